# Optimizing an MI355X kernel written in HIP

```python
import math
import jax, jax.numpy as jnp
from jax import lax
import numpy as np

D_MODEL = 1024
BATCH = 8
SEQ = 2048
DEPTH = 1

N_MEM = 256
GDN_HEADS = 8
GDN_DK = 128
GDN_DV = 128
GDN_KW = GDN_HEADS * GDN_DK
GDN_VW = GDN_HEADS * GDN_DV
SHORT_CONV = 4
CHUNK = 64
CONV_CH = D_MODEL
CONV_WIDTH = 31
XATTN_HEADS = 4
XATTN_HD = D_MODEL // XATTN_HEADS
D_FF = 2816
QKV_W = 2 * GDN_KW + GDN_VW
IN_SIZES = (QKV_W, GDN_VW, GDN_HEADS, GDN_HEADS, 2 * CONV_CH, 2 * D_MODEL)
IN_WIDTH = QKV_W + GDN_VW + 2 * GDN_HEADS + 2 * CONV_CH + 2 * D_MODEL
DN_ALPHA = (2 * DEPTH) ** 0.25
DN_BETA = (8 * DEPTH) ** -0.25
LN_EPS = 1e-5
RMS_EPS = 1e-6

kernel_name = "hybrid_gdn_conformer_deepnorm_block"


def layer_norm(x, g, b):
    xf = x.astype(jnp.float32)
    mu = jnp.mean(xf, axis=-1, keepdims=True)
    var = jnp.mean(jnp.square(xf - mu), axis=-1, keepdims=True)
    y = (xf - mu) * lax.rsqrt(var + LN_EPS)
    return (y * g.astype(jnp.float32) + b.astype(jnp.float32)).astype(x.dtype)


def rms_norm(x, g):
    xf = x.astype(jnp.float32)
    y = xf * lax.rsqrt(jnp.mean(jnp.square(xf), axis=-1, keepdims=True) + RMS_EPS)
    return (y * g.astype(jnp.float32)).astype(x.dtype)


def l2_normalize(x):
    return x * lax.rsqrt(jnp.sum(jnp.square(x), axis=-1, keepdims=True) + RMS_EPS)


def causal_depthwise_conv(x, w):
    k = w.shape[0]
    return lax.conv_general_dilated(
        x, w[:, None, :].astype(x.dtype), window_strides=(1,), padding=[(k - 1, 0)],
        dimension_numbers=("NWC", "WIO", "NWC"), feature_group_count=x.shape[-1])


def swiglu_ffn(x, w_gate, w_up, w_down):
    return (jax.nn.silu(x @ w_gate) * (x @ w_up)) @ w_down


def chunk_gated_delta_rule(q, k, v, g, beta):
    b, l, h, dk = q.shape
    dv = v.shape[-1]
    n = l // CHUNK
    q = l2_normalize(q) * (dk ** -0.5)
    k = l2_normalize(k)

    def chunks(t):
        return t.reshape(b, n, CHUNK, h, -1).transpose(0, 3, 1, 2, 4)

    qc, kc, vc = chunks(q), chunks(k), chunks(v)
    gc = jnp.cumsum(g.reshape(b, n, CHUNK, h).transpose(0, 3, 1, 2), axis=-1)
    bc = beta.reshape(b, n, CHUNK, h).transpose(0, 3, 1, 2)
    kb = kc * bc[..., None]
    vb = vc * bc[..., None]

    tri = jnp.tril(jnp.ones((CHUNK, CHUNK), dtype=bool))
    strict = jnp.tril(jnp.ones((CHUNK, CHUNK), dtype=bool), -1)
    diff = gc[..., :, None] - gc[..., None, :]
    decay = jnp.where(tri, jnp.exp(jnp.where(tri, diff, 0.0)), 0.0)

    m = jnp.where(strict, jnp.einsum("bhncd,bhnmd->bhncm", kb, kc) * decay, 0.0)
    t_sys = jnp.eye(CHUNK, dtype=q.dtype) + m
    u = lax.linalg.triangular_solve(t_sys, vb, left_side=True, lower=True, unit_diagonal=True)
    w = lax.linalg.triangular_solve(t_sys, kb * jnp.exp(gc)[..., None], left_side=True,
                                    lower=True, unit_diagonal=True)
    a_qk = jnp.einsum("bhncd,bhnmd->bhncm", qc, kc) * decay

    def step(state, xs):
        q_i, k_i, u_i, w_i, a_i, g_i = xs
        v_new = u_i - jnp.einsum("bhcd,bhde->bhce", w_i, state)
        o_i = (jnp.einsum("bhcd,bhde->bhce", q_i * jnp.exp(g_i)[..., None], state)
               + jnp.einsum("bhcm,bhme->bhce", a_i, v_new))
        g_last = g_i[..., -1]
        k_dec = k_i * jnp.exp(g_last[..., None] - g_i)[..., None]
        state = state * jnp.exp(g_last)[..., None, None] + jnp.einsum("bhcd,bhce->bhde", k_dec, v_new)
        return state, o_i

    xs = tuple(jnp.moveaxis(t, 2, 0) for t in (qc, kc, u, w, a_qk, gc))
    s0 = jnp.zeros((b, h, dk, dv), dtype=q.dtype)
    _, o = lax.scan(step, s0, xs)
    return o.transpose(1, 0, 3, 2, 4).reshape(b, l, h, dv)


def parallel_mixers(h, w_in, gdn_conv_qkv, gdn_a_log, gdn_dt_bias, gdn_norm_g, w_gdn_out,
                    conv_dw_w, conv_dw_b, conv_ln_g, conv_ln_b, w_conv_out, b_conv_out, w_mix_out):
    b, l, _ = h.shape
    proj = h @ w_in
    offs = np.cumsum(IN_SIZES)[:-1].tolist()
    qkv, z, a, bt, glu, gates = jnp.split(proj, offs, axis=-1)

    qkv = jax.nn.silu(causal_depthwise_conv(qkv, gdn_conv_qkv))
    q, k, v = jnp.split(qkv, [GDN_KW, 2 * GDN_KW], axis=-1)
    q = q.reshape(b, l, GDN_HEADS, GDN_DK)
    k = k.reshape(b, l, GDN_HEADS, GDN_DK)
    v = v.reshape(b, l, GDN_HEADS, GDN_DV)
    af = a.astype(jnp.float32)
    g = -jnp.exp(gdn_a_log.astype(jnp.float32)) * jax.nn.softplus(af + gdn_dt_bias.astype(jnp.float32))
    beta = jax.nn.sigmoid(bt.astype(jnp.float32))
    o = chunk_gated_delta_rule(q.astype(jnp.float32), k.astype(jnp.float32),
                               v.astype(jnp.float32), g, beta).astype(h.dtype)
    o = rms_norm(o, gdn_norm_g) * jax.nn.silu(z.reshape(b, l, GDN_HEADS, GDN_DV))
    y_a = o.reshape(b, l, GDN_VW) @ w_gdn_out

    c_lin, c_gate = jnp.split(glu, 2, axis=-1)
    c = c_lin * jax.nn.sigmoid(c_gate)
    c = causal_depthwise_conv(c, conv_dw_w) + conv_dw_b
    c = jax.nn.silu(layer_norm(c, conv_ln_g, conv_ln_b))
    y_c = c @ w_conv_out + b_conv_out

    g_a, g_c = jnp.split(gates, 2, axis=-1)
    y = jax.nn.sigmoid(g_a) * y_a + jax.nn.sigmoid(g_c) * y_c
    return y @ w_mix_out


def memory_cross_attention(x, mem, w_xq, w_xkv, w_xo):
    b, l, _ = x.shape
    q = (x @ w_xq).reshape(b, l, XATTN_HEADS, XATTN_HD)
    k, v = jnp.split(mem @ w_xkv, 2, axis=-1)
    k = k.reshape(b, -1, XATTN_HEADS, XATTN_HD)
    v = v.reshape(b, -1, XATTN_HEADS, XATTN_HD)
    s = jnp.einsum("blhd,bmhd->bhlm", q, k).astype(jnp.float32) * (XATTN_HD ** -0.5)
    p = jax.nn.softmax(s, axis=-1).astype(v.dtype)
    o = jnp.einsum("bhlm,bmhd->blhd", p, v).reshape(b, l, D_MODEL)
    return o @ w_xo


def setup_inputs(seed: int = 0) -> dict:
    key = jax.random.key(seed)
    keys = jax.random.split(key, 48)
    counter = [0]

    def nk():
        kk = keys[counter[0]]
        counter[0] += 1
        return kk

    def nrm(shape, scale):
        return jax.random.normal(nk(), shape, jnp.float32) * scale

    def gain(shape):
        return 1.0 + nrm(shape, 0.02)

    L = DEPTH
    dt = jnp.exp(jax.random.uniform(nk(), (L, GDN_HEADS), jnp.float32,
                                    minval=math.log(1e-3), maxval=math.log(0.1)))
    return {
        "x": nrm((BATCH, SEQ, D_MODEL), 1.0),
        "mem": nrm((BATCH, N_MEM, D_MODEL), 1.0),
        "ffn1_wg": nrm((L, D_MODEL, D_FF), D_MODEL ** -0.5),
        "ffn1_wu": nrm((L, D_MODEL, D_FF), D_MODEL ** -0.5),
        "ffn1_wd": nrm((L, D_FF, D_MODEL), DN_BETA * D_FF ** -0.5),
        "ln1_g": gain((L, D_MODEL)),
        "ln1_b": nrm((L, D_MODEL), 0.02),
        "w_in": nrm((L, D_MODEL, IN_WIDTH), D_MODEL ** -0.5),
        "gdn_conv_qkv": nrm((L, SHORT_CONV, QKV_W), SHORT_CONV ** -0.5),
        "gdn_a_log": jnp.log(jax.random.uniform(nk(), (L, GDN_HEADS), jnp.float32, minval=1.0, maxval=16.0)),
        "gdn_dt_bias": dt + jnp.log(-jnp.expm1(-dt)),
        "gdn_norm_g": gain((L, GDN_DV)),
        "w_gdn_out": nrm((L, GDN_VW, D_MODEL), GDN_VW ** -0.5),
        "conv_dw_w": nrm((L, CONV_WIDTH, CONV_CH), CONV_WIDTH ** -0.5),
        "conv_dw_b": nrm((L, CONV_CH), 0.02),
        "conv_ln_g": gain((L, CONV_CH)),
        "conv_ln_b": nrm((L, CONV_CH), 0.02),
        "w_conv_out": nrm((L, CONV_CH, D_MODEL), CONV_CH ** -0.5),
        "b_conv_out": nrm((L, D_MODEL), 0.02),
        "w_mix_out": nrm((L, D_MODEL, D_MODEL), DN_BETA * D_MODEL ** -0.5),
        "ln2_g": gain((L, D_MODEL)),
        "ln2_b": nrm((L, D_MODEL), 0.02),
        "w_xq": nrm((L, D_MODEL, D_MODEL), D_MODEL ** -0.5),
        "w_xkv": nrm((L, D_MODEL, 2 * D_MODEL), D_MODEL ** -0.5),
        "w_xo": nrm((L, D_MODEL, D_MODEL), DN_BETA * D_MODEL ** -0.5),
        "ln3_g": gain((L, D_MODEL)),
        "ln3_b": nrm((L, D_MODEL), 0.02),
        "ffn2_wg": nrm((L, D_MODEL, D_FF), D_MODEL ** -0.5),
        "ffn2_wu": nrm((L, D_MODEL, D_FF), D_MODEL ** -0.5),
        "ffn2_wd": nrm((L, D_FF, D_MODEL), DN_BETA * D_FF ** -0.5),
        "ln4_g": gain((L, D_MODEL)),
        "ln4_b": nrm((L, D_MODEL), 0.02),
    }


def reference(x, mem, ffn1_wg, ffn1_wu, ffn1_wd, ln1_g, ln1_b,
              w_in, gdn_conv_qkv, gdn_a_log, gdn_dt_bias, gdn_norm_g, w_gdn_out,
              conv_dw_w, conv_dw_b, conv_ln_g, conv_ln_b, w_conv_out, b_conv_out, w_mix_out,
              ln2_g, ln2_b, w_xq, w_xkv, w_xo, ln3_g, ln3_b,
              ffn2_wg, ffn2_wu, ffn2_wd, ln4_g, ln4_b):
    for i in range(DEPTH):
        x = layer_norm(DN_ALPHA * x + 0.5 * swiglu_ffn(x, ffn1_wg[i], ffn1_wu[i], ffn1_wd[i]),
                       ln1_g[i], ln1_b[i])
        y = parallel_mixers(x, w_in[i], gdn_conv_qkv[i], gdn_a_log[i], gdn_dt_bias[i], gdn_norm_g[i],
                            w_gdn_out[i], conv_dw_w[i], conv_dw_b[i], conv_ln_g[i], conv_ln_b[i],
                            w_conv_out[i], b_conv_out[i], w_mix_out[i])
        x = layer_norm(DN_ALPHA * x + y, ln2_g[i], ln2_b[i])
        x = layer_norm(DN_ALPHA * x + memory_cross_attention(x, mem, w_xq[i], w_xkv[i], w_xo[i]),
                       ln3_g[i], ln3_b[i])
        x = layer_norm(DN_ALPHA * x + 0.5 * swiglu_ffn(x, ffn2_wg[i], ffn2_wu[i], ffn2_wd[i]),
                       ln4_g[i], ln4_b[i])
    return x
```

```cpp
#include <hip/hip_runtime.h>
#include <hip/hip_cooperative_groups.h>
#include <cstdint>
#include <cstdio>
namespace cg = cooperative_groups;

namespace pg8 {
#define PG8_LAS __attribute__((address_space(3)))
typedef unsigned short bf16_t;
typedef short bf16x8 __attribute__((ext_vector_type(8)));
typedef float f32x4 __attribute__((ext_vector_type(4)));
typedef float f32x2 __attribute__((ext_vector_type(2)));
typedef unsigned u32x4 __attribute__((ext_vector_type(4)));
typedef unsigned u32x2 __attribute__((ext_vector_type(2)));
constexpr int BM = 256, BK = 64, HALF = 128, HTB = HALF * BK * 2, STAGE_BYTES = 8 * HTB, NXCD = 8, WGM = 8;

__host__ __device__ __forceinline__ int lds_byte(int r, int c) { const int st = (r >> 4) * 2 + (c >> 5), rr = r & 15, cc = c & 31, ob = rr * 64 + cc * 2; return st * 1024 + (ob ^ (((ob >> 9) & 1) << 5)); }
__host__ __device__ __forceinline__ void stage_rc(int b, int& R, int& C) { const int st = b / 1024, sb = b % 1024, swz = sb ^ (((sb >> 9) & 1) << 5); R = (st >> 1) * 16 + swz / 64; C = (st & 1) * 32 + (swz % 64) / 2; }
__host__ __device__ __forceinline__ int perm32(int rho) { const int n = rho >> 4, i = rho & 15; return 8 * (i >> 2) + 4 * n + (i & 3); }

struct Unit { int pm, pn; unsigned aoff, boff; int tag; };
struct Gemm { const bf16_t* A; const bf16_t* Bt; int K, lda, ldb; };

struct StaticOrder {
    int nM, nN, nwg, G, c;
    __device__ void init(int M, int N, int G_, int c_) { nM = M / BM; nN = N / BM; nwg = nM * nN; G = G_; c = c_; }
    __device__ bool next(int i, Unit& u) const {
        const long L = (long)i * G + c; if (L >= nwg) return false;
        int wgid = (int)L; { const int q = nwg / NXCD, r = nwg % NXCD, xcd = wgid % NXCD, off = wgid / NXCD; wgid = (xcd < r ? xcd * (q + 1) : r * (q + 1) + (xcd - r) * q) + off; }
        const int nig = WGM * nN, gid = wgid / nig, fm = gid * WGM, gsz = (nM - fm) < WGM ? (nM - fm) : WGM;
        u.pm = fm + ((wgid % nig) % gsz); u.pn = (wgid % nig) / gsz; u.aoff = 0; u.boff = 0; u.tag = 0; return true;
    }
    __device__ __forceinline__ void a_ready(const Unit&) const {}
    __device__ __forceinline__ void done(const Unit&) const {}
};
struct SingleUnit {
    Unit u0;
    __device__ bool next(int i, Unit& u) const { if (i != 0) return false; u = u0; return true; }
    __device__ __forceinline__ void a_ready(const Unit&) const {}
    __device__ __forceinline__ void done(const Unit&) const {}
};
struct KVOrder {
    int G, c;
    __device__ bool next(int i, Unit& u) const { const int cc = (c + G - (128 % G)) % G; const int L = i * G + cc; if (L >= 64) return false; u.pm = L >> 3; u.pn = L & 7; u.aoff = 0; u.boff = 0; u.tag = L; return true; }
    __device__ __forceinline__ void a_ready(const Unit&) const {}
    __device__ __forceinline__ void done(const Unit&) const {}
};

typedef __bf16 bf16x2_hw __attribute__((ext_vector_type(2)));
__device__ __forceinline__ unsigned cvt_pk_bf16(float lo, float hi) { f32x2 v = {lo, hi}; bf16x2_hw b = __builtin_convertvector(v, bf16x2_hw); return __builtin_bit_cast(unsigned, b); }
__device__ __forceinline__ float bf_lo(unsigned w) { return __uint_as_float(w << 16); }
__device__ __forceinline__ float bf_hi(unsigned w) { return __uint_as_float(w & 0xffff0000u); }
__device__ __forceinline__ float sigm(float x) { return __builtin_amdgcn_rcpf(1.f + __expf(-x)); }
__device__ __forceinline__ float silu(float x) { return x * sigm(x); }
__device__ __forceinline__ u32x4 pack8(const f32x4 a, const f32x4 b) { u32x4 w; w.x = cvt_pk_bf16(a[0], a[1]); w.y = cvt_pk_bf16(a[2], a[3]); w.z = cvt_pk_bf16(b[0], b[1]); w.w = cvt_pk_bf16(b[2], b[3]); return w; }


template <int MODE> struct EpiPair {
    static constexpr bool PERM = true, AFTER_DRAIN = false;
    bf16_t* O; int ldc; int pn0;
    __device__ __forceinline__ void operator()(const f32x4 (&acc)[2][2][4][2], const Unit& u, int wr, int wc, int fr, int fq) const {
        const int row0 = u.pm * BM + wr * 64 + fr, col0 = (u.pn - pn0) * HALF + wc * 32 + 8 * fq;
#pragma unroll
        for (int ai = 0; ai < 2; ++ai)
#pragma unroll
            for (int m = 0; m < 4; ++m) {
                f32x4 o[2];
#pragma unroll
                for (int n = 0; n < 2; ++n)
#pragma unroll
                    for (int i = 0; i < 4; ++i) { const float l = acc[ai][0][m][n][i], r = acc[ai][1][m][n][i]; o[n][i] = MODE == 0 ? silu(l) * r : l * sigm(r); }
                *(u32x4*)(O + (size_t)(row0 + ai * HALF + m * 16) * ldc + col0) = pack8(o[0], o[1]);
            }
    }
};
template <int ACT> struct EpiAct {
    static constexpr bool PERM = true, AFTER_DRAIN = false;
    bf16_t* O; int ldc; int pn0;
    __device__ __forceinline__ void operator()(const f32x4 (&acc)[2][2][4][2], const Unit& u, int wr, int wc, int fr, int fq) const {
        const int row0 = u.pm * BM + wr * 64 + fr, col0 = (u.pn - pn0) * BM + wc * 32 + 8 * fq;
#pragma unroll
        for (int ai = 0; ai < 2; ++ai)
#pragma unroll
            for (int m = 0; m < 4; ++m)
#pragma unroll
                for (int bj = 0; bj < 2; ++bj) {
                    f32x4 o[2];
#pragma unroll
                    for (int n = 0; n < 2; ++n)
#pragma unroll
                        for (int i = 0; i < 4; ++i) { const float v = acc[ai][bj][m][n][i]; o[n][i] = ACT == 1 ? silu(v) : (ACT == 2 ? sigm(v) : v); }
                    *(u32x4*)(O + (size_t)(row0 + ai * HALF + m * 16) * ldc + col0 + bj * HALF) = pack8(o[0], o[1]);
                }
    }
};
struct EpiQKV {
    static constexpr bool PERM = true, AFTER_DRAIN = false;
    bf16_t* QKV; bf16_t* HALO; float* AB;
    __device__ __forceinline__ void operator()(const f32x4 (&acc)[2][2][4][2], const Unit& u, int wr, int wc, int fr, int fq) const {
        const int row0 = u.pm * BM + wr * 64 + fr;
        if (u.pn < 12) {
            const int col0 = u.pn * BM + wc * 32 + 8 * fq;
#pragma unroll
            for (int ai = 0; ai < 2; ++ai)
#pragma unroll
                for (int m = 0; m < 4; ++m) {
                    const int row = row0 + ai * HALF + m * 16;
#pragma unroll
                    for (int bj = 0; bj < 2; ++bj) {
                        const u32x4 w = pack8(acc[ai][bj][m][0], acc[ai][bj][m][1]);
                        *(u32x4*)(QKV + (size_t)row * 3072 + col0 + bj * HALF) = w;
                        if ((row & 63) >= 61) *(u32x4*)(HALO + (size_t)((row >> 6) * 3 + (row & 63) - 61) * 3072 + col0 + bj * HALF) = w;
                    }
                }
        } else if (wc == 0 && fq < 2) {
#pragma unroll
            for (int ai = 0; ai < 2; ++ai)
#pragma unroll
                for (int m = 0; m < 4; ++m) {
                    float* p = AB + (size_t)(row0 + ai * HALF + m * 16) * 16 + 8 * fq;
                    *(f32x4*)p = acc[ai][0][m][0]; *(f32x4*)(p + 4) = acc[ai][0][m][1];
                }
        }
    }
};
struct EpiZGG {
    static constexpr bool PERM = true, AFTER_DRAIN = false;
    bf16_t* Z; bf16_t* C; bf16_t* G;
    __device__ __forceinline__ void operator()(const f32x4 (&acc)[2][2][4][2], const Unit& u, int wr, int wc, int fr, int fq) const {
        if (u.pn < 4) { EpiAct<1> e{Z, 1024, 0}; e(acc, u, wr, wc, fr, fq); }
        else if (u.pn < 12) { EpiPair<1> e{C, 1024, 4}; e(acc, u, wr, wc, fr, fq); }
        else { EpiAct<2> e{G, 2048, 12}; e(acc, u, wr, wc, fr, fq); }
    }
};
struct EpiGate1 {
    static constexpr bool PERM = true, AFTER_DRAIN = false;
    const bf16_t* G; bf16_t* T;
    __device__ __forceinline__ void operator()(const f32x4 (&acc)[2][2][4][2], const Unit& u, int wr, int wc, int fr, int fq) const {
        const int row0 = u.pm * BM + wr * 64 + fr, col0 = u.pn * BM + wc * 32 + 8 * fq;
#pragma unroll
        for (int ai = 0; ai < 2; ++ai)
#pragma unroll
            for (int m = 0; m < 4; ++m)
#pragma unroll
                for (int bj = 0; bj < 2; ++bj) {
                    const size_t r = (size_t)(row0 + ai * HALF + m * 16); const int c = col0 + bj * HALF;
                    const u32x4 g = *(const u32x4*)(G + r * 2048 + c);
                    f32x4 a = acc[ai][bj][m][0], b = acc[ai][bj][m][1];
                    a[0] *= bf_lo(g.x); a[1] *= bf_hi(g.x); a[2] *= bf_lo(g.y); a[3] *= bf_hi(g.y); b[0] *= bf_lo(g.z); b[1] *= bf_hi(g.z); b[2] *= bf_lo(g.w); b[3] *= bf_hi(g.w);
                    *(u32x4*)(T + r * 1024 + c) = pack8(a, b);
                }
    }
};
struct EpiGate2 {
    static constexpr bool PERM = true, AFTER_DRAIN = false;
    const bf16_t* G; const bf16_t* T; const float* bias; bf16_t* Y;
    __device__ __forceinline__ void operator()(const f32x4 (&acc)[2][2][4][2], const Unit& u, int wr, int wc, int fr, int fq) const {
        const int row0 = u.pm * BM + wr * 64 + fr, col0 = u.pn * BM + wc * 32 + 8 * fq;
#pragma unroll
        for (int bj = 0; bj < 2; ++bj) {
            const int c = col0 + bj * HALF;
            const f32x4 b0 = *(const f32x4*)(bias + c), b1 = *(const f32x4*)(bias + c + 4);
#pragma unroll
            for (int ai = 0; ai < 2; ++ai)
#pragma unroll
                for (int m = 0; m < 4; ++m) {
                    const size_t r = (size_t)(row0 + ai * HALF + m * 16);
                    const u32x4 g = *(const u32x4*)(G + r * 2048 + 1024 + c), t = *(const u32x4*)(T + r * 1024 + c);
                    f32x4 a = acc[ai][bj][m][0] + b0, b = acc[ai][bj][m][1] + b1;
                    a[0] = bf_lo(t.x) + a[0] * bf_lo(g.x); a[1] = bf_hi(t.x) + a[1] * bf_hi(g.x); a[2] = bf_lo(t.y) + a[2] * bf_lo(g.y); a[3] = bf_hi(t.y) + a[3] * bf_hi(g.y);
                    b[0] = bf_lo(t.z) + b[0] * bf_lo(g.z); b[1] = bf_hi(t.z) + b[1] * bf_hi(g.z); b[2] = bf_lo(t.w) + b[2] * bf_lo(g.w); b[3] = bf_hi(t.w) + b[3] * bf_hi(g.w);
                    *(u32x4*)(Y + r * 1024 + c) = pack8(a, b);
                }
        }
    }
};
template <bool RES_BF16> struct EpiResid {
    static constexpr bool PERM = false, AFTER_DRAIN = false;
    const void* res; float* out; float alpha, s;
    __device__ __forceinline__ void operator()(const f32x4 (&acc)[2][2][4][2], const Unit& u, int wr, int wc, int fr, int fq) const {
        const int row0 = u.pm * BM + wr * 64 + fr, col0 = u.pn * BM + wc * 32 + 4 * fq;
#pragma unroll
        for (int ai = 0; ai < 2; ++ai)
#pragma unroll
            for (int m = 0; m < 4; ++m)
#pragma unroll
                for (int bj = 0; bj < 2; ++bj)
#pragma unroll
                    for (int n = 0; n < 2; ++n) {
                        const size_t off = (size_t)(row0 + ai * HALF + m * 16) * 1024 + col0 + bj * HALF + n * 16;
                        f32x4 r;
                        if (RES_BF16) { const u32x2 w = *(const u32x2*)((const bf16_t*)res + off); r = (f32x4){bf_lo(w.x), bf_hi(w.x), bf_lo(w.y), bf_hi(w.y)}; }
                        else r = *(const f32x4*)((const float*)res + off);
                        *(f32x4*)(out + off) = r * alpha + acc[ai][bj][m][n] * s;
                    }
    }
};
struct EpiPlainNP {
    static constexpr bool PERM = false, AFTER_DRAIN = false;
    bf16_t* O; int ldc; int mode;
    __device__ __forceinline__ void operator()(const f32x4 (&acc)[2][2][4][2], const Unit& u, int wr, int wc, int fr, int fq) const {
        int rb = u.pm * BM, cb = u.pn * BM;
        if (mode == 1) { const int L = u.tag; rb = (L >> 5) * 2048 + (L & 7) * 256; cb = ((L >> 3) & 3) * 256; }
        const int row0 = rb + wr * 64 + fr, col0 = cb + wc * 32 + 4 * fq;
#pragma unroll
        for (int ai = 0; ai < 2; ++ai)
#pragma unroll
            for (int m = 0; m < 4; ++m)
#pragma unroll
                for (int bj = 0; bj < 2; ++bj)
#pragma unroll
                    for (int n = 0; n < 2; ++n) {
                        const f32x4 v = acc[ai][bj][m][n]; u32x2 w; w.x = cvt_pk_bf16(v[0], v[1]); w.y = cvt_pk_bf16(v[2], v[3]);
                        *(u32x2*)(O + (size_t)(row0 + ai * HALF + m * 16) * ldc + col0 + bj * HALF + n * 16) = w;
                    }
    }
};
struct EpiKV {
    static constexpr bool PERM = false, AFTER_DRAIN = false;
    bf16_t* Kb; bf16_t* VT;
    __device__ __forceinline__ void operator()(const f32x4 (&acc)[2][2][4][2], const Unit& u, int wr, int wc, int fr, int fq) const {
        if (u.pn < 4) { EpiPlainNP e{Kb, 1024, 0}; e(acc, u, wr, wc, fr, fq); return; }
        const int h = u.pn - 4, b = u.pm; bf16_t* base = VT + (size_t)(b * 4 + h) * 65536;
#pragma unroll
        for (int ai = 0; ai < 2; ++ai)
#pragma unroll
            for (int m = 0; m < 4; ++m) {
                const int mem = ai * HALF + wr * 64 + m * 16 + fr;
#pragma unroll
                for (int bj = 0; bj < 2; ++bj)
#pragma unroll
                    for (int n = 0; n < 2; ++n) {
                        const f32x4 v = acc[ai][bj][m][n]; const int hd = bj * HALF + wc * 32 + n * 16 + 4 * fq;
                        const unsigned w0 = cvt_pk_bf16(v[0], v[1]), w1 = cvt_pk_bf16(v[2], v[3]);
                        base[(size_t)(hd + 0) * 256 + mem] = (bf16_t)(w0 & 0xffffu); base[(size_t)(hd + 1) * 256 + mem] = (bf16_t)(w0 >> 16);
                        base[(size_t)(hd + 2) * 256 + mem] = (bf16_t)(w1 & 0xffffu); base[(size_t)(hd + 3) * 256 + mem] = (bf16_t)(w1 >> 16);
                    }
            }
    }
};
struct EpiSoftmax {
    static constexpr bool PERM = false, AFTER_DRAIN = true;
    bf16_t* P; float scale;
    __device__ __forceinline__ void fused(f32x4 (&acc)[2][2][4][2], const Unit& u, int wr, int wc, int fr, int fq, PG8_LAS unsigned char* lds, int wid, int lane) const {
        PG8_LAS float* PM = (PG8_LAS float*)lds;
        PG8_LAS float* PS = (PG8_LAS float*)(lds + 4096);
        const float sc = scale * 1.4426950408889634f;
#pragma unroll
        for (int ai = 0; ai < 2; ++ai)
#pragma unroll
            for (int m = 0; m < 4; ++m) {
                float mx = -3.0e38f;
#pragma unroll
                for (int bj = 0; bj < 2; ++bj)
#pragma unroll
                    for (int n = 0; n < 2; ++n) { f32x4 v = acc[ai][bj][m][n] * sc; acc[ai][bj][m][n] = v; mx = fmaxf(mx, fmaxf(fmaxf(v[0], v[1]), fmaxf(v[2], v[3]))); }
                mx = fmaxf(mx, __shfl_xor(mx, 16)); mx = fmaxf(mx, __shfl_xor(mx, 32));
                if (fq == 0) PM[(ai * HALF + wr * 64 + m * 16 + fr) * 4 + wc] = mx;
            }
        asm volatile("s_waitcnt lgkmcnt(0)" ::: "memory"); __builtin_amdgcn_s_barrier(); asm volatile("" ::: "memory");
#pragma unroll
        for (int ai = 0; ai < 2; ++ai)
#pragma unroll
            for (int m = 0; m < 4; ++m) {
                const int r = ai * HALF + wr * 64 + m * 16 + fr;
                const f32x4 pm = *(const PG8_LAS f32x4*)(PM + r * 4);
                const float mx = fmaxf(fmaxf(pm[0], pm[1]), fmaxf(pm[2], pm[3]));
                float s = 0.f;
#pragma unroll
                for (int bj = 0; bj < 2; ++bj)
#pragma unroll
                    for (int n = 0; n < 2; ++n) { f32x4 v = acc[ai][bj][m][n]; v[0] = __builtin_amdgcn_exp2f(v[0] - mx); v[1] = __builtin_amdgcn_exp2f(v[1] - mx); v[2] = __builtin_amdgcn_exp2f(v[2] - mx); v[3] = __builtin_amdgcn_exp2f(v[3] - mx);
                        acc[ai][bj][m][n] = v; s += (v[0] + v[1]) + (v[2] + v[3]); }
                s += __shfl_xor(s, 16); s += __shfl_xor(s, 32);
                if (fq == 0) PS[r * 4 + wc] = s;
            }
        asm volatile("s_waitcnt lgkmcnt(0)" ::: "memory"); __builtin_amdgcn_s_barrier(); asm volatile("" ::: "memory");
        const int L = u.tag;
#pragma unroll
        for (int ai = 0; ai < 2; ++ai)
#pragma unroll
            for (int m = 0; m < 4; ++m) {
                const int r = ai * HALF + wr * 64 + m * 16 + fr;
                const f32x4 ps = *(const PG8_LAS f32x4*)(PS + r * 4);
                const float inv = 1.0f / ((ps[0] + ps[1]) + (ps[2] + ps[3]));
#pragma unroll
                for (int bj = 0; bj < 2; ++bj)
#pragma unroll
                    for (int n = 0; n < 2; ++n) { const f32x4 v = acc[ai][bj][m][n] * inv; u32x2 w; w.x = cvt_pk_bf16(v[0], v[1]); w.y = cvt_pk_bf16(v[2], v[3]);
                        *(u32x2*)(P + ((size_t)L * 256 + r) * 256 + bj * HALF + wc * 32 + n * 16 + 4 * fq) = w; }
            }
        asm volatile("s_waitcnt lgkmcnt(0)" ::: "memory"); __builtin_amdgcn_s_barrier(); asm volatile("" ::: "memory");
    }
};

template <class Epi, class Sched, bool ALIGN_EPI = false, bool SP2 = false>
__device__ __forceinline__ void gemm_phase(PG8_LAS unsigned char* lds, const Gemm g, const Sched& S, const Epi& E) {
    const int tid = threadIdx.x, wid = __builtin_amdgcn_readfirstlane(tid >> 6), lane = tid & 63, wr = wid >> 2, wc = wid & 3, fr = lane & 15, fq = lane >> 4;
    const int K = g.K, nt = K / BK;
    unsigned voffA[2], voffB[2];
#pragma unroll
    for (int i = 0; i < 2; ++i) { int R, C; stage_rc(tid * 16 + i * 8192, R, C); const int Rb = Epi::PERM ? ((R & ~31) + perm32(R & 31)) : R;
        voffA[i] = (unsigned)(R * g.lda + C) * 2u; voffB[i] = (unsigned)(Rb * g.ldb + C) * 2u; }
    const size_t kstep = (size_t)(BK * 2);
    const size_t hstepA = (size_t)HALF * g.lda * 2, hstepB = (size_t)HALF * g.ldb * 2;
    const size_t tstepA = 2 * hstepA, tstepB = 2 * hstepB;
    const unsigned ldsw = (unsigned)wid * 1024u;
    const int aoff = lds_byte(wr * 64 + fr, fq * 8), boff = lds_byte(wc * 32 + fr, fq * 8);
#define PG8_SA(b, h) (((b) * 2 + (h)) * HTB)
#define PG8_SB(b, h) ((4 + (b) * 2 + (h)) * HTB)
#define PG8_STAGE(bufoff, gbase, voff) do { _Pragma("unroll") for (int _i = 0; _i < 2; ++_i) \
        __builtin_amdgcn_global_load_lds((const unsigned*)((const char*)(gbase) + (voff)[_i]), (PG8_LAS unsigned*)(lds + (bufoff) + ldsw + _i * 8192), 16, 0, 0); } while (0)
#define PG8_LDA(dst, b, h) do { _Pragma("unroll") for (int m = 0; m < 4; ++m) _Pragma("unroll") for (int k = 0; k < 2; ++k) dst[m][k] = *(const PG8_LAS bf16x8*)(lds + PG8_SA(b, h) + aoff + m * 2048 + k * 1024); } while (0)
#define PG8_LDB(dst, b, h) do { _Pragma("unroll") for (int n = 0; n < 2; ++n) _Pragma("unroll") for (int k = 0; k < 2; ++k) dst[n][k] = *(const PG8_LAS bf16x8*)(lds + PG8_SB(b, h) + boff + n * 2048 + k * 1024); } while (0)
#define PG8_MMA(ai, bj, At, Bt) do { __builtin_amdgcn_s_setprio(1); _Pragma("unroll") for (int m = 0; m < 4; ++m) _Pragma("unroll") for (int n = 0; n < 2; ++n) _Pragma("unroll") for (int k = 0; k < 2; ++k) \
        acc[ai][bj][m][n] = __builtin_amdgcn_mfma_f32_16x16x32_bf16(Bt[n][k], At[m][k], acc[ai][bj][m][n], 0, 0, 0); __builtin_amdgcn_s_setprio(0); } while (0)
#define PG8_WAIT_V(n) asm volatile("s_waitcnt vmcnt(" #n ")" ::: "memory")
#define PG8_WAIT_L(n) asm volatile("s_waitcnt lgkmcnt(" #n ")" ::: "memory")
#define PG8_BAR __builtin_amdgcn_s_barrier()
#define PG8_SCHED __builtin_amdgcn_sched_barrier(0)
    Unit cur, nxt; int ui = 0;
    if (!S.next(0, cur)) return;
    f32x4 acc[2][2][4][2];
#pragma unroll
    for (int a = 0; a < 2; ++a)
#pragma unroll
        for (int b = 0; b < 2; ++b)
#pragma unroll
            for (int m = 0; m < 4; ++m)
#pragma unroll
                for (int n = 0; n < 2; ++n) acc[a][b][m][n] = (f32x4){0.f, 0.f, 0.f, 0.f};
    bf16x8 At[4][2], B0[2][2], B1[2][2];
    const char* cA = (const char*)g.A + (size_t)cur.pm * tstepA + cur.aoff; const char* cB = (const char*)g.Bt + (size_t)cur.pn * tstepB + cur.boff;
    S.a_ready(cur);
    if constexpr (SP2) {
        PG8_STAGE(PG8_SB(0, 0), cB, voffB); PG8_STAGE(PG8_SB(0, 1), cB + hstepB, voffB); PG8_STAGE(PG8_SA(0, 0), cA, voffA); PG8_STAGE(PG8_SA(0, 1), cA + hstepA, voffA);
        if (wr == 1) PG8_BAR;
        PG8_WAIT_V(2); PG8_BAR;
        PG8_STAGE(PG8_SB(1, 0), cB + kstep, voffB); PG8_STAGE(PG8_SA(1, 0), cA + kstep, voffA); PG8_STAGE(PG8_SB(1, 1), cB + hstepB + kstep, voffB);
        PG8_WAIT_V(6); PG8_BAR;
    } else {
        PG8_STAGE(PG8_SB(0, 0), cB, voffB); PG8_STAGE(PG8_SA(0, 0), cA, voffA); PG8_STAGE(PG8_SB(0, 1), cB + hstepB, voffB); PG8_STAGE(PG8_SA(0, 1), cA + hstepA, voffA);
        if (wr == 1) PG8_BAR;
        PG8_WAIT_V(4); PG8_BAR;
        PG8_STAGE(PG8_SB(1, 0), cB + kstep, voffB); PG8_STAGE(PG8_SA(1, 0), cA + kstep, voffA); PG8_STAGE(PG8_SB(1, 1), cB + hstepB + kstep, voffB);
        PG8_WAIT_V(6); PG8_BAR;
    }
    for (;;) {
        const bool has_next = S.next(ui + 1, nxt);
        const char* nA = has_next ? (const char*)g.A + (size_t)nxt.pm * tstepA + nxt.aoff : cA; const char* nB = has_next ? (const char*)g.Bt + (size_t)nxt.pn * tstepB + nxt.boff : cB;
        for (int t = 0; t < nt; t += 2) {
            const bool last = (t == nt - 2);
            const char* a1 = cA + (size_t)(t + 1) * kstep;
            const char* a2 = last ? nA : cA + (size_t)(t + 2) * kstep; const char* b2 = last ? nB : cB + (size_t)(t + 2) * kstep;
            const char* a3 = a2 + kstep; const char* b3 = b2 + kstep;
            if (last && has_next) S.a_ready(nxt);
            if constexpr (SP2) {
            PG8_LDB(B0, 0, 0); PG8_LDB(B1, 0, 1); PG8_SCHED; PG8_LDA(At, 0, 0); PG8_STAGE(PG8_SA(1, 1), a1 + hstepA, voffA);
            PG8_WAIT_V(8); PG8_WAIT_L(0); PG8_BAR; PG8_MMA(0, 0, At, B0); PG8_MMA(0, 1, At, B1); PG8_BAR; PG8_SCHED;
            PG8_LDA(At, 0, 1); PG8_STAGE(PG8_SB(0, 0), b2, voffB); PG8_STAGE(PG8_SB(0, 1), b2 + hstepB, voffB); PG8_STAGE(PG8_SA(0, 0), a2, voffA);
            PG8_WAIT_V(8); PG8_WAIT_L(0); PG8_BAR; PG8_MMA(1, 0, At, B0); PG8_MMA(1, 1, At, B1); PG8_BAR; PG8_SCHED;
            PG8_LDB(B0, 1, 0); PG8_LDB(B1, 1, 1); PG8_SCHED; PG8_LDA(At, 1, 0); PG8_STAGE(PG8_SA(0, 1), a2 + hstepA, voffA);
            PG8_WAIT_V(8); PG8_WAIT_L(0); PG8_BAR; PG8_MMA(0, 0, At, B0); PG8_MMA(0, 1, At, B1); PG8_BAR; PG8_SCHED;
            PG8_LDA(At, 1, 1); PG8_STAGE(PG8_SB(1, 0), b3, voffB); PG8_STAGE(PG8_SB(1, 1), b3 + hstepB, voffB); PG8_STAGE(PG8_SA(1, 0), a3, voffA);
            PG8_WAIT_V(8); PG8_WAIT_L(0); PG8_BAR; PG8_MMA(1, 0, At, B0); PG8_MMA(1, 1, At, B1); PG8_BAR; PG8_SCHED;
            } else {
            PG8_LDB(B0, 0, 0); PG8_SCHED; PG8_LDA(At, 0, 0); PG8_STAGE(PG8_SA(1, 1), a1 + hstepA, voffA);
            PG8_WAIT_L(8); PG8_BAR; PG8_WAIT_L(0); PG8_MMA(0, 0, At, B0); PG8_BAR; PG8_SCHED;
            PG8_LDB(B1, 0, 1); PG8_STAGE(PG8_SB(0, 0), b2, voffB);
            PG8_BAR; PG8_WAIT_L(0); PG8_MMA(0, 1, At, B1); PG8_BAR;
            PG8_LDA(At, 0, 1); PG8_STAGE(PG8_SA(0, 0), a2, voffA);
            PG8_BAR; PG8_WAIT_L(0); PG8_MMA(1, 0, At, B0); PG8_BAR; PG8_SCHED;
            PG8_STAGE(PG8_SB(0, 1), b2 + hstepB, voffB);
            PG8_WAIT_V(6); PG8_BAR; PG8_MMA(1, 1, At, B1); PG8_BAR;
            PG8_LDB(B0, 1, 0); PG8_SCHED; PG8_LDA(At, 1, 0); PG8_STAGE(PG8_SA(0, 1), a2 + hstepA, voffA);
            PG8_WAIT_L(8); PG8_BAR; PG8_WAIT_L(0); PG8_MMA(0, 0, At, B0); PG8_BAR; PG8_SCHED;
            PG8_LDB(B1, 1, 1); PG8_STAGE(PG8_SB(1, 0), b3, voffB);
            PG8_BAR; PG8_WAIT_L(0); PG8_MMA(0, 1, At, B1); PG8_BAR;
            PG8_LDA(At, 1, 1); PG8_STAGE(PG8_SA(1, 0), a3, voffA);
            PG8_BAR; PG8_WAIT_L(0); PG8_MMA(1, 0, At, B0); PG8_BAR; PG8_SCHED;
            PG8_STAGE(PG8_SB(1, 1), b3 + hstepB, voffB);
            PG8_WAIT_V(6); PG8_BAR; PG8_MMA(1, 1, At, B1); PG8_BAR;
            }
        }
        if constexpr (ALIGN_EPI) { if (wr == 0) PG8_BAR; }
        if constexpr (!Epi::AFTER_DRAIN) { E(acc, cur, wr, wc, fr, fq); S.done(cur); }
        if (!has_next) break;
#pragma unroll
        for (int a = 0; a < 2; ++a)
#pragma unroll
            for (int b = 0; b < 2; ++b)
#pragma unroll
                for (int m = 0; m < 4; ++m)
#pragma unroll
                    for (int n = 0; n < 2; ++n) acc[a][b][m][n] = (f32x4){0.f, 0.f, 0.f, 0.f};
        cur = nxt; cA = nA; cB = nB; ++ui;
        if constexpr (ALIGN_EPI) { if (wr == 1) PG8_BAR; }
    }
    PG8_WAIT_V(0);
    if constexpr (!ALIGN_EPI) { if (wr == 0) PG8_BAR; }
    PG8_BAR;
    if constexpr (Epi::AFTER_DRAIN) { E.fused(acc, cur, wr, wc, fr, fq, lds, wid, lane); S.done(cur); }
#undef PG8_SA
#undef PG8_SB
#undef PG8_STAGE
#undef PG8_LDA
#undef PG8_LDB
#undef PG8_MMA
#undef PG8_WAIT_V
#undef PG8_WAIT_L
#undef PG8_BAR
#undef PG8_SCHED
}
}

using pg8::bf16_t; using pg8::f32x4; using pg8::u32x4; using pg8::u32x2; using pg8::bf16x8;
#define LAS __attribute__((address_space(3)))

constexpr int DM = 1024, NB = 8, SEQ = 2048, M = NB * SEQ, DFF = 2816, NMEM = 256, NH = 8, DK = 128, CW = 31;
constexpr float ALPHA = 1.189207115002721f, LN_EPS = 1e-5f, RMS_EPS = 1e-6f;
constexpr int NWAVES = 8, NTHR = 512;
constexpr int LDS_BYTES = 147456;

constexpr size_t MiB = 1u << 20;
constexpr size_t W_GU1 = 0, W_D1 = 11 * MiB, W_GU2 = 16 * MiB + MiB / 2, W_D2 = 27 * MiB + MiB / 2, W_INA = 33 * MiB, W_INB = 39 * MiB + MiB / 2,
                 W_GDN = 49 * MiB + MiB / 2, W_CONV = 51 * MiB + MiB / 2, W_MIX = 53 * MiB + MiB / 2, W_XQ = 55 * MiB + MiB / 2, W_XO = 57 * MiB + MiB / 2, W_XKV = 59 * MiB + MiB / 2;
constexpr size_t WS_CTL = 63 * MiB + MiB / 2 + 4096;
constexpr size_t WS_XB = 64 * MiB, WS_K = 96 * MiB, WS_VT = 100 * MiB, WS_R = 104 * MiB;
constexpr size_t WS_H = WS_R;
constexpr size_t WS_MEMB = 248 * MiB;
constexpr size_t WS_QKV = WS_R, WS_KT = 200 * MiB, WS_AQK = 232 * MiB, WS_HALO = 248 * MiB, WS_EGC = 253 * MiB, WS_AB = 254 * MiB;
constexpr size_t WS_C = WS_R, WS_G = 136 * MiB, WS_CC = 200 * MiB, WS_YMIX = WS_R;
constexpr size_t WS_Q = WS_R, WS_P = 136 * MiB, WS_O = 168 * MiB;

struct Args { const float* in[32]; float* out; unsigned char* ws; int ph_lo, ph_hi; };

struct Seg { int in, K, N, col0, ncols, row0, type; unsigned long long dst; };
__constant__ Seg c_seg[18] = {
    {2, 1024, 2816, 0, 2816, 0, 1, W_GU1}, {3, 1024, 2816, 0, 2816, 128, 1, W_GU1}, {4, 2816, 1024, 0, 1024, 0, 0, W_D1},
    {27, 1024, 2816, 0, 2816, 0, 1, W_GU2}, {28, 1024, 2816, 0, 2816, 128, 1, W_GU2}, {29, 2816, 1024, 0, 1024, 0, 0, W_D2},
    {7, 1024, 8208, 0, 3072, 0, 0, W_INA}, {7, 1024, 8208, 4096, 32, 3072, 0, W_INA},
    {7, 1024, 8208, 3072, 1024, 0, 0, W_INB}, {7, 1024, 8208, 4112, 1024, 1024, 1, W_INB}, {7, 1024, 8208, 5136, 1024, 1152, 1, W_INB}, {7, 1024, 8208, 6160, 2048, 3072, 0, W_INB},
    {12, 1024, 1024, 0, 1024, 0, 0, W_GDN}, {17, 1024, 1024, 0, 1024, 0, 0, W_CONV}, {19, 1024, 1024, 0, 1024, 0, 0, W_MIX}, {22, 1024, 1024, 0, 1024, 0, 0, W_XQ}, {24, 1024, 1024, 0, 1024, 0, 0, W_XO},
    {23, 1024, 2048, 0, 2048, 0, 0, W_XKV}};

__device__ __forceinline__ float wave_sum(float v) {
#pragma unroll
    for (int o = 1; o < 64; o <<= 1) v += __shfl_xor(v, o);
    return v;
}
__device__ __forceinline__ unsigned pk2(float lo, float hi) { return pg8::cvt_pk_bf16(lo, hi); }
__device__ __forceinline__ float bflo(unsigned w) { return __uint_as_float(w << 16); }
__device__ __forceinline__ float bfhi(unsigned w) { return __uint_as_float(w & 0xffff0000u); }
__device__ __forceinline__ float bf1(bf16_t h) { return __uint_as_float(((unsigned)h) << 16); }
__device__ __forceinline__ bf16_t tobf(float f) { return (bf16_t)(pg8::cvt_pk_bf16(f, 0.f) & 0xffffu); }

__device__ __forceinline__ void p0_item(const float* W, int K, int N, int col0, bf16_t* WT, int row0, int type, LAS float* scr, int item, int ncols, int lane) {
    const int nblk = ncols / 32, kb = item / nblk, nb = item % nblk, k0 = 64 * kb, n0 = 32 * nb;
#pragma unroll 8
    for (int i = 0; i < 32; ++i) { const int kk = 2 * i + (lane >> 5); scr[kk * 33 + (lane & 31)] = W[(size_t)(k0 + kk) * N + col0 + n0 + (lane & 31)]; }
    asm volatile("s_waitcnt lgkmcnt(0)" ::: "memory");
    const int c = lane & 7;
#pragma unroll
    for (int j = 0; j < 4; ++j) { const int n = (lane >> 3) + 8 * j; const LAS float* s = scr + (8 * c) * 33 + n;
        u32x4 o; o.x = pk2(s[0 * 33], s[1 * 33]); o.y = pk2(s[2 * 33], s[3 * 33]); o.z = pk2(s[4 * 33], s[5 * 33]); o.w = pk2(s[6 * 33], s[7 * 33]);
        const int nn = n0 + n; const int drow = type ? row0 + 256 * (nn >> 7) + (nn & 127) : row0 + nn;
        *(u32x4*)(WT + (size_t)drow * K + k0 + 8 * c) = o; }
    asm volatile("s_waitcnt lgkmcnt(0)" ::: "memory");
}
__device__ __forceinline__ void phase_prologue(const Args& a, LAS unsigned char* lds, int gw, int NGW, int wave, int lane) {
    LAS float* scr = (LAS float*)(lds + wave * 16384);
    int total = 0;
#pragma unroll 1
    for (int s = 0; s < 18; ++s) total += (c_seg[s].K / 64) * (c_seg[s].ncols / 32);
    for (int it = gw; it < total; it += NGW) {
        int r = it, s = 0;
        for (;; ++s) { const int cnt = (c_seg[s].K / 64) * (c_seg[s].ncols / 32); if (r < cnt) break; r -= cnt; }
        p0_item(a.in[c_seg[s].in], c_seg[s].K, c_seg[s].N, c_seg[s].col0, (bf16_t*)(a.ws + c_seg[s].dst), c_seg[s].row0, c_seg[s].type, scr, r, c_seg[s].ncols, lane);
    }
    { u32x4* z = (u32x4*)(a.ws + W_INA + (size_t)3104 * 1024 * 2); for (int i = gw * 64 + lane; i < 458752 / 16; i += NGW * 64) z[i] = (u32x4){0u, 0u, 0u, 0u}; }
    { const f32x4* x = (const f32x4*)a.in[0]; u32x4* o = (u32x4*)(a.ws + WS_XB);
      for (int i = gw * 64 + lane; i < M * DM / 8; i += NGW * 64) { const f32x4 v0 = x[2 * i], v1 = x[2 * i + 1]; o[i] = pg8::pack8(v0, v1); } }
    { const f32x4* x = (const f32x4*)a.in[1]; u32x4* o = (u32x4*)(a.ws + WS_MEMB);
      for (int i = gw * 64 + lane; i < NB * NMEM * DM / 8; i += NGW * 64) { const f32x4 v0 = x[2 * i], v1 = x[2 * i + 1]; o[i] = pg8::pack8(v0, v1); } }
}

__device__ __forceinline__ void phase_ln(const float* src, float* dstf, bf16_t* dstb, const float* g, const float* b, int gw, int NGW, int lane) {
    f32x4 gg[4], bb[4];
#pragma unroll
    for (int j = 0; j < 4; ++j) { gg[j] = ((const f32x4*)g)[lane + 64 * j]; bb[j] = ((const f32x4*)b)[lane + 64 * j]; }
    for (int m = gw; m < M; m += NGW) {
        const f32x4* xr = (const f32x4*)(src + (size_t)m * DM) + lane;
        f32x4 v[4]; float s = 0.f;
#pragma unroll
        for (int j = 0; j < 4; ++j) { v[j] = xr[64 * j]; s += (v[j][0] + v[j][1]) + (v[j][2] + v[j][3]); }
        const float mean = wave_sum(s) * (1.f / DM); float s2 = 0.f;
#pragma unroll
        for (int j = 0; j < 4; ++j) { v[j] = v[j] - mean; s2 += (v[j][0] * v[j][0] + v[j][1] * v[j][1]) + (v[j][2] * v[j][2] + v[j][3] * v[j][3]); }
        const float rstd = 1.f / sqrtf(wave_sum(s2) * (1.f / DM) + LN_EPS);
#pragma unroll
        for (int j = 0; j < 4; ++j) { v[j] = v[j] * rstd * gg[j] + bb[j]; }
        if (dstf) {
            f32x4* o = (f32x4*)(dstf + (size_t)m * DM) + lane;
#pragma unroll
            for (int j = 0; j < 4; ++j) o[64 * j] = v[j];
        }
        if (dstb) {
            u32x2* o = (u32x2*)(dstb + (size_t)m * DM) + lane;
#pragma unroll
            for (int j = 0; j < 4; ++j) { u32x2 w; w.x = pk2(v[j][0], v[j][1]); w.y = pk2(v[j][2], v[j][3]); o[64 * j] = w; }
        }
    }
}

__device__ __forceinline__ void phase_conv31(const bf16_t* C, bf16_t* CC, const float* w, const float* bias, const float* lg, const float* lb, LAS unsigned char* lds, int G, int tid) {
    LAS float* tile = (LAS float*)lds;
    const int wave = tid >> 6, lane = tid & 63;
    float w0[CW], w1[CW];
#pragma unroll
    for (int j = 0; j < CW; ++j) { const float2 t = *(const float2*)(w + (size_t)j * DM + 2 * tid); w0[j] = t.x; w1[j] = t.y; }
    const float2 bs = *(const float2*)(bias + 2 * tid);
    f32x4 gg[4], bb[4];
#pragma unroll
    for (int j = 0; j < 4; ++j) { gg[j] = ((const f32x4*)lg)[lane + 64 * j]; bb[j] = ((const f32x4*)lb)[lane + 64 * j]; }
    for (int it = blockIdx.x; it < M / 8; it += G) {
        const int t0 = it * 8, s0 = t0 & (SEQ - 1);
        float a0[8], a1[8];
#pragma unroll
        for (int o = 0; o < 8; ++o) { a0[o] = bs.x; a1[o] = bs.y; }
#pragma unroll
        for (int r = -(CW - 1); r < 8; ++r) {
            unsigned xw = 0u;
            if (s0 + r >= 0) xw = *(const unsigned*)(C + (size_t)(t0 + r) * DM + 2 * tid);
            const float x0 = bflo(xw), x1 = bfhi(xw);
#pragma unroll
            for (int o = 0; o < 8; ++o) { const int j = r - o + (CW - 1); if (j >= 0 && j < CW) { a0[o] += x0 * w0[j]; a1[o] += x1 * w1[j]; } }
        }
#pragma unroll
        for (int o = 0; o < 8; ++o) *(LAS pg8::f32x2*)(tile + o * DM + 2 * tid) = (pg8::f32x2){a0[o], a1[o]};
        __syncthreads();
        {
            const LAS f32x4* xr = (const LAS f32x4*)(tile + wave * DM) + lane;
            f32x4 v[4]; float s = 0.f;
#pragma unroll
            for (int j = 0; j < 4; ++j) { v[j] = xr[64 * j]; s += (v[j][0] + v[j][1]) + (v[j][2] + v[j][3]); }
            const float mean = wave_sum(s) * (1.f / DM); float s2 = 0.f;
#pragma unroll
            for (int j = 0; j < 4; ++j) { v[j] = v[j] - mean; s2 += (v[j][0] * v[j][0] + v[j][1] * v[j][1]) + (v[j][2] * v[j][2] + v[j][3] * v[j][3]); }
            const float rstd = 1.f / sqrtf(wave_sum(s2) * (1.f / DM) + LN_EPS);
            u32x2* o = (u32x2*)(CC + (size_t)(t0 + wave) * DM) + lane;
#pragma unroll
            for (int j = 0; j < 4; ++j) { f32x4 y = v[j] * rstd * gg[j] + bb[j]; u32x2 ww; ww.x = pk2(pg8::silu(y[0]), pg8::silu(y[1])); ww.y = pk2(pg8::silu(y[2]), pg8::silu(y[3])); o[64 * j] = ww; }
        }
        __syncthreads();
    }
}

__device__ __forceinline__ void phase_gate_rms(bf16_t* O, const bf16_t* Z, const float* gn, int gw, int NGW, int lane) {
    f32x4 g4[4];
#pragma unroll
    for (int j = 0; j < 4; ++j) g4[j] = ((const f32x4*)gn)[(lane & 7) * 4 + j];
    for (int m = gw; m < M; m += NGW) {
        u32x4* op = (u32x4*)(O + (size_t)m * DM) + 2 * lane; const u32x4* zp = (const u32x4*)(Z + (size_t)m * DM) + 2 * lane;
        const u32x4 o0 = op[0], o1 = op[1], z0 = zp[0], z1 = zp[1];
        float v[16] = {bflo(o0.x), bfhi(o0.x), bflo(o0.y), bfhi(o0.y), bflo(o0.z), bfhi(o0.z), bflo(o0.w), bfhi(o0.w), bflo(o1.x), bfhi(o1.x), bflo(o1.y), bfhi(o1.y), bflo(o1.z), bfhi(o1.z), bflo(o1.w), bfhi(o1.w)};
        float zz[16] = {bflo(z0.x), bfhi(z0.x), bflo(z0.y), bfhi(z0.y), bflo(z0.z), bfhi(z0.z), bflo(z0.w), bfhi(z0.w), bflo(z1.x), bfhi(z1.x), bflo(z1.y), bfhi(z1.y), bflo(z1.z), bfhi(z1.z), bflo(z1.w), bfhi(z1.w)};
        float ss = 0.f;
#pragma unroll
        for (int i = 0; i < 16; ++i) ss += v[i] * v[i];
        ss += __shfl_xor(ss, 1); ss += __shfl_xor(ss, 2); ss += __shfl_xor(ss, 4);
        const float rstd = 1.f / sqrtf(ss * (1.f / 128.f) + RMS_EPS);
#pragma unroll
        for (int i = 0; i < 16; ++i) v[i] = v[i] * rstd * g4[i >> 2][i & 3] * zz[i];
        u32x4 r0, r1; r0.x = pk2(v[0], v[1]); r0.y = pk2(v[2], v[3]); r0.z = pk2(v[4], v[5]); r0.w = pk2(v[6], v[7]); r1.x = pk2(v[8], v[9]); r1.y = pk2(v[10], v[11]); r1.z = pk2(v[12], v[13]); r1.w = pk2(v[14], v[15]);
        op[0] = r0; op[1] = r1;
    }
}

constexpr int PREP_HALF = 4 * 17408 + 1024;
static_assert(2 * PREP_HALF <= LDS_BYTES, "prep LDS");
__device__ __forceinline__ void phase_gdn_prep(const Args& a, LAS unsigned char* lds, int G, int tid) {
    bf16_t* QKV = (bf16_t*)(a.ws + WS_QKV); const bf16_t* HALO = (const bf16_t*)(a.ws + WS_HALO); const float* AB = (const float*)(a.ws + WS_AB);
    bf16_t* KT = (bf16_t*)(a.ws + WS_KT); bf16_t* AQK = (bf16_t*)(a.ws + WS_AQK); float* EGC = (float*)(a.ws + WS_EGC);
    const float* convw = a.in[8]; const float* a_log = a.in[9]; const float* dt_bias = a.in[10];
    const int hw = tid >> 8, t = tid & 255, wv = (tid >> 6) & 3, lane = tid & 63;
    LAS unsigned char* base = lds + hw * PREP_HALF;
    LAS bf16_t* Kb = (LAS bf16_t*)base; LAS bf16_t* Qb = (LAS bf16_t*)(base + 17408); LAS bf16_t* Vb = (LAS bf16_t*)(base + 2 * 17408);
    LAS float* Mf = (LAS float*)(base + 3 * 17408); LAS float* gcs = (LAS float*)(base + 4 * 17408); LAS float* betas = gcs + 64;
    for (int it = blockIdx.x; it < 1024; it += G) {
        const int ch = it * 2 + hw, b = ch >> 8, h = (ch >> 5) & 7, n = ch & 31;
        const int row0 = b * SEQ + n * 64;
        if (wv == 0) {
            const float av = AB[(size_t)(row0 + lane) * 16 + h], bv = AB[(size_t)(row0 + lane) * 16 + 8 + h];
            const float xx = av + dt_bias[h];
            const float sp = xx > 20.f ? xx : log1pf(expf(xx));
            float g = -expf(a_log[h]) * sp;
#pragma unroll
            for (int o = 1; o < 64; o <<= 1) { const float up = __shfl_up(g, o); if (lane >= o) g += up; }
            gcs[lane] = g; betas[lane] = pg8::sigm(bv);
        }
        {
            const int cgp = t & 15, rb = t >> 4;
#pragma unroll
            for (int ten = 0; ten < 3; ++ten) {
                const int colb = ten * 1024 + h * 128 + cgp * 8;
                f32x4 w[4][2];
#pragma unroll
                for (int j = 0; j < 4; ++j) { w[j][0] = *(const f32x4*)(convw + (size_t)j * 3072 + colb); w[j][1] = *(const f32x4*)(convw + (size_t)j * 3072 + colb + 4); }
#pragma unroll
                for (int i4 = 0; i4 < 4; ++i4) {
                    const int c = rb + 16 * i4;
                    float o[8] = {0.f, 0.f, 0.f, 0.f, 0.f, 0.f, 0.f, 0.f};
#pragma unroll
                    for (int j = 0; j < 4; ++j) {
                        const int rr = c - 3 + j; u32x4 x = (u32x4){0u, 0u, 0u, 0u};
                        if (rr >= 0) x = *(const u32x4*)(QKV + (size_t)(row0 + rr) * 3072 + colb);
                        else if (n > 0) x = *(const u32x4*)(HALO + (size_t)((b * 32 + n - 1) * 3 + 3 + rr) * 3072 + colb);
                        o[0] += bflo(x.x) * w[j][0][0]; o[1] += bfhi(x.x) * w[j][0][1]; o[2] += bflo(x.y) * w[j][0][2]; o[3] += bfhi(x.y) * w[j][0][3];
                        o[4] += bflo(x.z) * w[j][1][0]; o[5] += bfhi(x.z) * w[j][1][1]; o[6] += bflo(x.w) * w[j][1][2]; o[7] += bfhi(x.w) * w[j][1][3];
                    }
                    float ss = 0.f;
#pragma unroll
                    for (int i = 0; i < 8; ++i) { o[i] = pg8::silu(o[i]); ss += o[i] * o[i]; }
                    if (ten < 2) {
                        ss += __shfl_xor(ss, 1); ss += __shfl_xor(ss, 2); ss += __shfl_xor(ss, 4); ss += __shfl_xor(ss, 8);
                        const float sc = (1.f / sqrtf(ss + RMS_EPS)) * (ten == 0 ? 0.08838834764831845f : 1.f);
#pragma unroll
                        for (int i = 0; i < 8; ++i) o[i] *= sc;
                    }
                    u32x4 pk; pk.x = pk2(o[0], o[1]); pk.y = pk2(o[2], o[3]); pk.z = pk2(o[4], o[5]); pk.w = pk2(o[6], o[7]);
                    LAS bf16_t* dst = (ten == 0 ? Qb : (ten == 1 ? Kb : Vb)) + c * 136 + cgp * 8;
                    *(LAS u32x4*)dst = pk;
                }
            }
        }
        __syncthreads();
#pragma unroll
        for (int i4 = 0; i4 < 4; ++i4) { const int c = (t >> 4) + 16 * i4, cgp = t & 15;
            *(u32x4*)(QKV + (size_t)(row0 + c) * 3072 + h * 128 + cgp * 8) = *(const LAS u32x4*)(Qb + c * 136 + cgp * 8); }
        {
            const int ct = wv, l15 = lane & 15, q4 = lane >> 4;
            bf16x8 ak[4], aq[4];
#pragma unroll
            for (int ks = 0; ks < 4; ++ks) { ak[ks] = *(const LAS bf16x8*)(Kb + (ct * 16 + l15) * 136 + ks * 32 + q4 * 8); aq[ks] = *(const LAS bf16x8*)(Qb + (ct * 16 + l15) * 136 + ks * 32 + q4 * 8); }
            float gcr[4], btr[4];
#pragma unroll
            for (int r = 0; r < 4; ++r) { gcr[r] = gcs[ct * 16 + q4 * 4 + r]; btr[r] = betas[ct * 16 + q4 * 4 + r]; }
#pragma unroll
            for (int mt = 0; mt < 4; ++mt) {
                f32x4 kk = (f32x4){0.f, 0.f, 0.f, 0.f}, qk = (f32x4){0.f, 0.f, 0.f, 0.f};
                if (mt <= ct) {
#pragma unroll
                    for (int ks = 0; ks < 4; ++ks) { const bf16x8 bk = *(const LAS bf16x8*)(Kb + (mt * 16 + l15) * 136 + ks * 32 + q4 * 8);
                        kk = __builtin_amdgcn_mfma_f32_16x16x32_bf16(ak[ks], bk, kk, 0, 0, 0); qk = __builtin_amdgcn_mfma_f32_16x16x32_bf16(aq[ks], bk, qk, 0, 0, 0); }
                }
                const int mcol = mt * 16 + l15; const float gcm = gcs[mcol];
#pragma unroll
                for (int r = 0; r < 4; ++r) {
                    const int c = ct * 16 + q4 * 4 + r; const float dec = __expf(fminf(gcr[r] - gcm, 0.f));
                    Mf[c * 68 + mcol] = (mcol < c) ? btr[r] * kk[r] * dec : 0.f;
                    AQK[(size_t)ch * 4096 + c * 64 + mcol] = tobf((mcol <= c) ? qk[r] * dec : 0.f);
                }
            }
        }
        __syncthreads();
        {
            const int j = wv * 64 + lane;
            float x[64];
            if (j < 128) {
#pragma unroll
                for (int c = 0; c < 64; ++c) { x[c] = bf1(Vb[c * 136 + j]) * betas[c]; if ((c & 7) == 7) asm volatile("" ::: "memory"); }
            } else {
#pragma unroll
                for (int c = 0; c < 64; ++c) { x[c] = bf1(Kb[c * 136 + j - 128]) * betas[c] * __expf(gcs[c]); if ((c & 7) == 7) asm volatile("" ::: "memory"); }
            }
#pragma unroll
            for (int c = 1; c < 64; ++c) {
                float s = x[c];
#pragma unroll
                for (int m4 = 0; m4 < (c + 3) / 4; ++m4) {
                    const f32x4 mm = *(const LAS f32x4*)(Mf + c * 68 + 4 * m4);
#pragma unroll
                    for (int k = 0; k < 4; ++k) if (4 * m4 + k < c) s -= mm[k] * x[4 * m4 + k];
                }
                x[c] = s;
                asm volatile("" ::: "memory");
            }
            bf16_t* dst = QKV + (size_t)row0 * 3072 + (j < 128 ? 2048 + h * 128 + j : 1024 + h * 128 + (j - 128));
#pragma unroll
            for (int c = 0; c < 64; ++c) dst[(size_t)c * 3072] = tobf(x[c]);
        }
        {
            const int d = t >> 1, c0 = (t & 1) * 32; const float gl = gcs[63];
#pragma unroll
            for (int c8 = 0; c8 < 4; ++c8) {
                float v[8];
#pragma unroll
                for (int i = 0; i < 8; ++i) { const int c = c0 + c8 * 8 + i; v[i] = bf1(Kb[c * 136 + d]) * __expf(gl - gcs[c]); }
                u32x4 pk; pk.x = pk2(v[0], v[1]); pk.y = pk2(v[2], v[3]); pk.z = pk2(v[4], v[5]); pk.w = pk2(v[6], v[7]);
                *(u32x4*)(KT + (size_t)ch * 8192 + d * 64 + c0 + c8 * 8) = pk;
            }
            if (t < 64) EGC[(size_t)ch * 64 + t] = __expf(gcs[t]);
        }
        __syncthreads();
    }
}

__device__ __forceinline__ void phase_gdn_scan(const Args& a, LAS unsigned char* lds, int G, int tid) {
    const bf16_t* QKV = (const bf16_t*)(a.ws + WS_QKV); const bf16_t* KT = (const bf16_t*)(a.ws + WS_KT); const bf16_t* AQK = (const bf16_t*)(a.ws + WS_AQK); const float* EGC = (const float*)(a.ws + WS_EGC);
    bf16_t* O = (bf16_t*)a.out;
    LAS bf16_t* ST = (LAS bf16_t*)lds;
    LAS bf16_t* VT = (LAS bf16_t*)(lds + 32 * 136 * 2);
    const int w = tid >> 6, lane = tid & 63, l15 = lane & 15, q4 = lane >> 4, ct = w >> 1, et = w & 1;
    for (int it = blockIdx.x; it < 256; it += G) {
        const int b = it >> 5, h = (it >> 2) & 7, e0 = (it & 3) * 32;
        f32x4 Sacc[2] = {(f32x4){0.f, 0.f, 0.f, 0.f}, (f32x4){0.f, 0.f, 0.f, 0.f}};
        for (int i = tid; i < 32 * 136 / 2; i += NTHR) ((LAS unsigned*)ST)[i] = 0u;
        __syncthreads();
        for (int n = 0; n < 32; ++n) {
            const int ch = (b * 8 + h) * 32 + n, row0 = b * SEQ + n * 64;
            const bf16_t* rowp = QKV + (size_t)(row0 + ct * 16 + l15) * 3072 + h * 128 + q4 * 8;
            bf16x8 qA[4], wA[4], aA[2], kA[2];
#pragma unroll
            for (int ks = 0; ks < 4; ++ks) { qA[ks] = *(const bf16x8*)(rowp + ks * 32); wA[ks] = *(const bf16x8*)(rowp + 1024 + ks * 32); }
#pragma unroll
            for (int ks = 0; ks < 2; ++ks) { aA[ks] = *(const bf16x8*)(AQK + (size_t)ch * 4096 + (ct * 16 + l15) * 64 + ks * 32 + q4 * 8); kA[ks] = *(const bf16x8*)(KT + (size_t)ch * 8192 + (w * 16 + l15) * 64 + ks * 32 + q4 * 8); }
            float uu[4], eg[4];
#pragma unroll
            for (int r = 0; r < 4; ++r) { const int c = ct * 16 + q4 * 4 + r; uu[r] = bf1(QKV[(size_t)(row0 + c) * 3072 + 2048 + h * 128 + e0 + et * 16 + l15]); eg[r] = EGC[(size_t)ch * 64 + c]; }
            const float egl = EGC[(size_t)ch * 64 + 63];
            f32x4 wsv = (f32x4){0.f, 0.f, 0.f, 0.f}, qsv = (f32x4){0.f, 0.f, 0.f, 0.f};
#pragma unroll
            for (int ks = 0; ks < 4; ++ks) { const bf16x8 sB = *(const LAS bf16x8*)(ST + (et * 16 + l15) * 136 + ks * 32 + q4 * 8);
                wsv = __builtin_amdgcn_mfma_f32_16x16x32_bf16(wA[ks], sB, wsv, 0, 0, 0); qsv = __builtin_amdgcn_mfma_f32_16x16x32_bf16(qA[ks], sB, qsv, 0, 0, 0); }
            { u32x2 pk; pk.x = pk2(uu[0] - wsv[0], uu[1] - wsv[1]); pk.y = pk2(uu[2] - wsv[2], uu[3] - wsv[3]);
              *(LAS u32x2*)(VT + (et * 16 + l15) * 72 + ct * 16 + q4 * 4) = pk; }
            __syncthreads();
            f32x4 av = (f32x4){0.f, 0.f, 0.f, 0.f};
#pragma unroll
            for (int ks = 0; ks < 2; ++ks) { const bf16x8 vB = *(const LAS bf16x8*)(VT + (et * 16 + l15) * 72 + ks * 32 + q4 * 8); av = __builtin_amdgcn_mfma_f32_16x16x32_bf16(aA[ks], vB, av, 0, 0, 0); }
#pragma unroll
            for (int r = 0; r < 4; ++r) { const int c = ct * 16 + q4 * 4 + r; O[(size_t)(row0 + c) * DM + h * 128 + e0 + et * 16 + l15] = tobf(qsv[r] * eg[r] + av[r]); }
#pragma unroll
            for (int e2 = 0; e2 < 2; ++e2) {
                f32x4 up = (f32x4){0.f, 0.f, 0.f, 0.f};
#pragma unroll
                for (int ks = 0; ks < 2; ++ks) { const bf16x8 vB = *(const LAS bf16x8*)(VT + (e2 * 16 + l15) * 72 + ks * 32 + q4 * 8); up = __builtin_amdgcn_mfma_f32_16x16x32_bf16(kA[ks], vB, up, 0, 0, 0); }
                Sacc[e2] = Sacc[e2] * egl + up;
                u32x2 pk; pk.x = pk2(Sacc[e2][0], Sacc[e2][1]); pk.y = pk2(Sacc[e2][2], Sacc[e2][3]);
                *(LAS u32x2*)(ST + (e2 * 16 + l15) * 136 + w * 16 + q4 * 4) = pk;
            }
            __syncthreads();
        }
    }
}

__device__ __forceinline__ void grid_bar(unsigned* cnt, unsigned target) {
    asm volatile("s_waitcnt vmcnt(0) lgkmcnt(0)" ::: "memory");
    __syncthreads();
    if (threadIdx.x == 0) {
        __builtin_amdgcn_fence(__ATOMIC_RELEASE, "agent");
        asm volatile("s_waitcnt vmcnt(0)" ::: "memory");
        __hip_atomic_fetch_add(cnt, 1u, __ATOMIC_RELAXED, __HIP_MEMORY_SCOPE_AGENT);
        unsigned spins = 0;
        while (__hip_atomic_load(cnt, __ATOMIC_RELAXED, __HIP_MEMORY_SCOPE_AGENT) < target) { __builtin_amdgcn_s_sleep(1); if (++spins > (1u << 24)) break; }
    }
    __syncthreads();
    asm volatile("buffer_inv sc1\n\ts_waitcnt vmcnt(0)" ::: "memory");
    __syncthreads();
}
struct AttnQKOrder {
    int G, c;
    __device__ bool next(int i, pg8::Unit& u) const { const int L = i * G + c; if (L >= 256) return false; const int b = L >> 5, h = (L >> 3) & 3, qt = L & 7;
        u.pm = b * 8 + qt; u.pn = b; u.aoff = (unsigned)h * 512u; u.boff = (unsigned)h * 512u; u.tag = L; return true; }
};
struct AttnPVOrder {
    int G, c;
    __device__ bool next(int i, pg8::Unit& u) const { const int L = i * G + c; if (L >= 256) return false; u.pm = L; u.pn = L >> 3; u.aoff = 0; u.boff = 0; u.tag = L; return true; }
    __device__ __forceinline__ void a_ready(const pg8::Unit&) const {}
    __device__ __forceinline__ void done(const pg8::Unit&) const {}
};

#ifndef PH_LAST
#define PH_LAST 19
#endif
#ifndef PH_MASK
#define PH_MASK 0xFFFFFu
#endif

__global__ void __launch_bounds__(NTHR, 2) fwd_kernel(Args a) {
    extern __shared__ __attribute__((aligned(16))) unsigned char lds_raw[];
    cg::grid_group grid = cg::this_grid();
    LAS unsigned char* lds = (LAS unsigned char*)lds_raw;
    const int tid = threadIdx.x, lane = tid & 63, wave = __builtin_amdgcn_readfirstlane(tid >> 6);
    const int G = gridDim.x, bx = blockIdx.x;
    const int gw = bx * NWAVES + wave, NGW = G * NWAVES;
    unsigned char* ws = a.ws;
    bf16_t* XB = (bf16_t*)(ws + WS_XB);
    float* XF = a.out;
    const int lo = a.ph_lo, hi = a.ph_hi;
    unsigned* bar_cnt = (unsigned*)(ws + WS_CTL); int bar_n = 0;
    if (lo > 1000) grid.sync();
#define IN(k) (lo <= (k) && (k) <= hi && (k) <= PH_LAST && ((PH_MASK >> (k)) & 1u))
#define SEAM(k) do { if (IN(k) && IN((k) + 1)) { ++bar_n; grid_bar(bar_cnt, (unsigned)bar_n * (unsigned)G); } } while (0)
    using namespace pg8;

    if (IN(0)) { phase_prologue(a, lds, gw, NGW, wave, lane); }
    SEAM(0);
    if (IN(1)) {
        { Gemm g{XB, (const bf16_t*)(ws + W_GU1), DM, DM, DM}; StaticOrder S; S.init(M, 2 * DFF, G, bx); EpiPair<0> E{(bf16_t*)(ws + WS_H), DFF, 0};
          gemm_phase<EpiPair<0>, StaticOrder, true, true>(lds, g, S, E); }
        __syncthreads();
        { Gemm g{(const bf16_t*)(ws + WS_MEMB), (const bf16_t*)(ws + W_XKV), DM, DM, DM}; KVOrder S{G, bx}; EpiKV E{(bf16_t*)(ws + WS_K), (bf16_t*)(ws + WS_VT)};
          gemm_phase<EpiKV, KVOrder, true, true>(lds, g, S, E); }
    }
    SEAM(1);
    if (IN(2)) {
        Gemm g{(const bf16_t*)(ws + WS_H), (const bf16_t*)(ws + W_D1), DFF, DFF, DFF}; StaticOrder S; S.init(M, DM, G, bx); EpiResid<false> E{a.in[0], XF, ALPHA, 0.5f};
        gemm_phase<EpiResid<false>, StaticOrder, true, true>(lds, g, S, E);
    }
    SEAM(2);
    if (IN(3)) phase_ln(XF, nullptr, XB, a.in[5], a.in[6], gw, NGW, lane);
    SEAM(3);
    if (IN(4)) {
        Gemm g{XB, (const bf16_t*)(ws + W_INA), DM, DM, DM}; StaticOrder S; S.init(M, 3328, G, bx); EpiQKV E{(bf16_t*)(ws + WS_QKV), (bf16_t*)(ws + WS_HALO), (float*)(ws + WS_AB)};
        gemm_phase<EpiQKV, StaticOrder, true, true>(lds, g, S, E);
    }
    SEAM(4);
    if (IN(5)) phase_gdn_prep(a, lds, G, tid);
    SEAM(5);
    if (IN(6)) phase_gdn_scan(a, lds, G, tid);
    SEAM(6);
    if (IN(7)) {
        { Gemm g{XB, (const bf16_t*)(ws + W_INB), DM, DM, DM}; StaticOrder S; S.init(M, 3072, G, bx); EpiZGG E{(bf16_t*)((unsigned char*)a.out + 32 * MiB), (bf16_t*)(ws + WS_C), (bf16_t*)(ws + WS_G)};
          gemm_phase<EpiZGG, StaticOrder, true, true>(lds, g, S, E); }
        __syncthreads();
        { Gemm g{XB, (const bf16_t*)(ws + W_INB) + (size_t)3072 * DM, DM, DM, DM}; StaticOrder S; S.init(M, 2048, G, bx); EpiAct<2> E{(bf16_t*)(ws + WS_G), 2048, 0};
          gemm_phase<EpiAct<2>, StaticOrder, true, true>(lds, g, S, E); }
    }
    SEAM(7);
    if (IN(8)) {
        phase_conv31((const bf16_t*)(ws + WS_C), (bf16_t*)(ws + WS_CC), a.in[13], a.in[14], a.in[15], a.in[16], lds, G, tid);
        phase_gate_rms((bf16_t*)a.out, (const bf16_t*)((unsigned char*)a.out + 32 * MiB), a.in[11], gw, NGW, lane);
    }
    SEAM(8);
    if (IN(9)) {
        bf16_t* T = (bf16_t*)((unsigned char*)a.out + 32 * MiB);
        { Gemm g{(const bf16_t*)a.out, (const bf16_t*)(ws + W_GDN), DM, DM, DM}; StaticOrder S; S.init(M, DM, G, bx); EpiGate1 E{(const bf16_t*)(ws + WS_G), T};
          gemm_phase<EpiGate1, StaticOrder, true, true>(lds, g, S, E); }
        __syncthreads();
        { Gemm g{(const bf16_t*)(ws + WS_CC), (const bf16_t*)(ws + W_CONV), DM, DM, DM}; StaticOrder S; S.init(M, DM, G, bx); EpiGate2 E{(const bf16_t*)(ws + WS_G), T, a.in[18], (bf16_t*)(ws + WS_YMIX)};
          gemm_phase<EpiGate2, StaticOrder, true, true>(lds, g, S, E); }
    }
    SEAM(9);
    if (IN(10)) {
        Gemm g{(const bf16_t*)(ws + WS_YMIX), (const bf16_t*)(ws + W_MIX), DM, DM, DM}; StaticOrder S; S.init(M, DM, G, bx); EpiResid<true> E{XB, XF, ALPHA, 1.0f};
        gemm_phase<EpiResid<true>, StaticOrder, true, true>(lds, g, S, E);
    }
    SEAM(10);
    if (IN(11)) phase_ln(XF, XF, XB, a.in[20], a.in[21], gw, NGW, lane);
    SEAM(11);
    if (IN(12)) {
        Gemm g{XB, (const bf16_t*)(ws + W_XQ), DM, DM, DM}; StaticOrder S; S.init(M, DM, G, bx); EpiAct<0> E{(bf16_t*)(ws + WS_Q), DM, 0};
        gemm_phase<EpiAct<0>, StaticOrder, true, true>(lds, g, S, E);
    }
    SEAM(12);
    if (IN(13)) {
        int k256 = 256; asm volatile("" : "+s"(k256));
        Gemm g{(const bf16_t*)(ws + WS_Q), (const bf16_t*)(ws + WS_K), k256, DM, DM}; AttnQKOrder S{G, bx}; EpiSoftmax E{(bf16_t*)(ws + WS_P), 0.0625f};
        Unit u;
        for (int i = 0; S.next(i, u); ++i) { SingleUnit s1{u}; gemm_phase<EpiSoftmax, SingleUnit, false, true>(lds, g, s1, E); __syncthreads(); }
    }
    SEAM(13);
    if (IN(14)) {
        int k256 = 256; asm volatile("" : "+s"(k256));
        Gemm g{(const bf16_t*)(ws + WS_P), (const bf16_t*)(ws + WS_VT), k256, 256, 256}; AttnPVOrder S{G, bx}; EpiPlainNP E{(bf16_t*)(ws + WS_O), DM, 1};
        gemm_phase<EpiPlainNP, AttnPVOrder, true, true>(lds, g, S, E);
    }
    SEAM(14);
    if (IN(15)) {
        Gemm g{(const bf16_t*)(ws + WS_O), (const bf16_t*)(ws + W_XO), DM, DM, DM}; StaticOrder S; S.init(M, DM, G, bx); EpiResid<false> E{XF, XF, ALPHA, 1.0f};
        gemm_phase<EpiResid<false>, StaticOrder, true, true>(lds, g, S, E);
    }
    SEAM(15);
    if (IN(16)) phase_ln(XF, XF, XB, a.in[25], a.in[26], gw, NGW, lane);
    SEAM(16);
    if (IN(17)) {
        Gemm g{XB, (const bf16_t*)(ws + W_GU2), DM, DM, DM}; StaticOrder S; S.init(M, 2 * DFF, G, bx); EpiPair<0> E{(bf16_t*)(ws + WS_H), DFF, 0};
        gemm_phase<EpiPair<0>, StaticOrder, true, true>(lds, g, S, E);
    }
    SEAM(17);
    if (IN(18)) {
        Gemm g{(const bf16_t*)(ws + WS_H), (const bf16_t*)(ws + W_D2), DFF, DFF, DFF}; StaticOrder S; S.init(M, DM, G, bx); EpiResid<false> E{XF, XF, ALPHA, 0.5f};
        gemm_phase<EpiResid<false>, StaticOrder, true, true>(lds, g, S, E);
    }
    SEAM(18);
    if (IN(19)) phase_ln(XF, XF, nullptr, a.in[30], a.in[31], gw, NGW, lane);
#undef IN
#undef SEAM
}

extern "C" void kernel_launch(void* const* d_in, const int* in_sizes, int n_in, void* d_out, int out_size, void* d_ws, size_t ws_size, hipStream_t stream) {
    static int grid_blocks = 0;
    if (!grid_blocks) {
        int dev = 0, cus = 0, per_cu = 0;
        hipGetDevice(&dev);
        hipDeviceGetAttribute(&cus, hipDeviceAttributeMultiprocessorCount, dev);
        hipFuncSetAttribute((const void*)fwd_kernel, hipFuncAttributeMaxDynamicSharedMemorySize, LDS_BYTES);
        hipOccupancyMaxActiveBlocksPerMultiprocessor(&per_cu, (const void*)fwd_kernel, NTHR, LDS_BYTES);
        if (per_cu < 1) { fprintf(stderr, "occupancy query says %d blocks/CU\n", per_cu); per_cu = 1; }
        grid_blocks = cus * per_cu;
        if (grid_blocks > 256) grid_blocks = 256;
    }
    (void)hipMemsetAsync((char*)d_ws + WS_CTL, 0, 256, stream);
    Args a{};
    for (int i = 0; i < 32; ++i) a.in[i] = (const float*)d_in[i];
    a.out = (float*)d_out; a.ws = (unsigned char*)d_ws; a.ph_lo = 0; a.ph_hi = 99;
    void* args[] = {&a};
    hipError_t e = hipLaunchCooperativeKernel((const void*)fwd_kernel, dim3(grid_blocks), dim3(NTHR), args, LDS_BYTES, stream);
    if (e != hipSuccess) fprintf(stderr, "cooperative launch failed: %s (grid %d)\n", hipGetErrorString(e), grid_blocks);
}
```

```cpp
#include <hip/hip_runtime.h>
#include <hip/hip_cooperative_groups.h>
#include <cstdint>
#include <cstdio>
namespace cg = cooperative_groups;

namespace pg8 {
#define PG8_LAS __attribute__((address_space(3)))
typedef unsigned short bf16_t;
typedef short bf16x8 __attribute__((ext_vector_type(8)));
typedef float f32x4 __attribute__((ext_vector_type(4)));
typedef float f32x2 __attribute__((ext_vector_type(2)));
typedef unsigned u32x4 __attribute__((ext_vector_type(4)));
typedef unsigned u32x2 __attribute__((ext_vector_type(2)));
constexpr int BM = 256, BK = 64, HALF = 128, HTB = HALF * BK * 2, STAGE_BYTES = 8 * HTB, NXCD = 8, WGM = 8;

__host__ __device__ __forceinline__ int lds_byte(int r, int c) { const int st = (r >> 4) * 2 + (c >> 5), rr = r & 15, cc = c & 31, ob = rr * 64 + cc * 2; return st * 1024 + (ob ^ (((ob >> 9) & 1) << 5)); }
__host__ __device__ __forceinline__ void stage_rc(int b, int& R, int& C) { const int st = b / 1024, sb = b % 1024, swz = sb ^ (((sb >> 9) & 1) << 5); R = (st >> 1) * 16 + swz / 64; C = (st & 1) * 32 + (swz % 64) / 2; }
__host__ __device__ __forceinline__ int perm32(int rho) { const int n = rho >> 4, i = rho & 15; return 8 * (i >> 2) + 4 * n + (i & 3); }

struct Unit { int pm, pn; unsigned aoff, boff; int tag; };
struct Gemm { const bf16_t* A; const bf16_t* Bt; int K, lda, ldb; };

struct StaticOrder {
    int nM, nN, nwg, G, c;
    __device__ __forceinline__ void init(int M, int N, int G_, int c_) { nM = M / BM; nN = N / BM; nwg = nM * nN; G = G_; c = c_; }
    __device__ __forceinline__ bool next(int i, Unit& u) const {
        const long L = (long)i * G + c; if (L >= nwg) return false;
        int wgid = (int)L; { const int q = nwg / NXCD, r = nwg % NXCD, xcd = wgid % NXCD, off = wgid / NXCD; wgid = (xcd < r ? xcd * (q + 1) : r * (q + 1) + (xcd - r) * q) + off; }
        const int nig = WGM * nN, gid = wgid / nig, fm = gid * WGM, gsz = (nM - fm) < WGM ? (nM - fm) : WGM;
        u.pm = fm + ((wgid % nig) % gsz); u.pn = (wgid % nig) / gsz; u.aoff = 0; u.boff = 0; u.tag = 0; return true;
    }
    __device__ __forceinline__ void a_ready(const Unit&) const {}
    __device__ __forceinline__ void done(const Unit&) const {}
};
struct SingleUnit {
    Unit u0;
    __device__ __forceinline__ bool next(int i, Unit& u) const { if (i != 0) return false; u = u0; return true; }
    __device__ __forceinline__ void a_ready(const Unit&) const {}
    __device__ __forceinline__ void done(const Unit&) const {}
};
struct KVOrder {
    int G, c;
    __device__ __forceinline__ bool next(int i, Unit& u) const { const int cc = (c + G - (128 % G)) % G; const int L = i * G + cc; if (L >= 64) return false; u.pm = L >> 3; u.pn = L & 7; u.aoff = 0; u.boff = 0; u.tag = L; return true; }
    __device__ __forceinline__ void a_ready(const Unit&) const {}
    __device__ __forceinline__ void done(const Unit&) const {}
};

typedef __bf16 bf16x2_hw __attribute__((ext_vector_type(2)));
__device__ __forceinline__ unsigned cvt_pk_bf16(float lo, float hi) { f32x2 v = {lo, hi}; bf16x2_hw b = __builtin_convertvector(v, bf16x2_hw); return __builtin_bit_cast(unsigned, b); }
__device__ __forceinline__ float bf_lo(unsigned w) { return __uint_as_float(w << 16); }
__device__ __forceinline__ float bf_hi(unsigned w) { return __uint_as_float(w & 0xffff0000u); }
__device__ __forceinline__ float sigm(float x) { return __builtin_amdgcn_rcpf(1.f + __expf(-x)); }
__device__ __forceinline__ float silu(float x) { return x * sigm(x); }
__device__ __forceinline__ u32x4 pack8(const f32x4 a, const f32x4 b) { u32x4 w; w.x = cvt_pk_bf16(a[0], a[1]); w.y = cvt_pk_bf16(a[2], a[3]); w.z = cvt_pk_bf16(b[0], b[1]); w.w = cvt_pk_bf16(b[2], b[3]); return w; }


template <int MODE> struct EpiPair {
    static constexpr bool PERM = true, AFTER_DRAIN = false;
    bf16_t* O; int ldc; int pn0;
    __device__ __forceinline__ void operator()(const f32x4 (&acc)[2][2][4][2], const Unit& u, int wr, int wc, int fr, int fq) const {
        const int row0 = u.pm * BM + wr * 64 + fr, col0 = (u.pn - pn0) * HALF + wc * 32 + 8 * fq;
#pragma unroll
        for (int ai = 0; ai < 2; ++ai)
#pragma unroll
            for (int m = 0; m < 4; ++m) {
                f32x4 o[2];
#pragma unroll
                for (int n = 0; n < 2; ++n)
#pragma unroll
                    for (int i = 0; i < 4; ++i) { const float l = acc[ai][0][m][n][i], r = acc[ai][1][m][n][i]; o[n][i] = MODE == 0 ? silu(l) * r : l * sigm(r); }
                *(u32x4*)(O + (size_t)(row0 + ai * HALF + m * 16) * ldc + col0) = pack8(o[0], o[1]);
            }
    }
};
template <int ACT> struct EpiAct {
    static constexpr bool PERM = true, AFTER_DRAIN = false;
    bf16_t* O; int ldc; int pn0;
    __device__ __forceinline__ void operator()(const f32x4 (&acc)[2][2][4][2], const Unit& u, int wr, int wc, int fr, int fq) const {
        const int row0 = u.pm * BM + wr * 64 + fr, col0 = (u.pn - pn0) * BM + wc * 32 + 8 * fq;
#pragma unroll
        for (int ai = 0; ai < 2; ++ai)
#pragma unroll
            for (int m = 0; m < 4; ++m)
#pragma unroll
                for (int bj = 0; bj < 2; ++bj) {
                    f32x4 o[2];
#pragma unroll
                    for (int n = 0; n < 2; ++n)
#pragma unroll
                        for (int i = 0; i < 4; ++i) { const float v = acc[ai][bj][m][n][i]; o[n][i] = ACT == 1 ? silu(v) : (ACT == 2 ? sigm(v) : v); }
                    *(u32x4*)(O + (size_t)(row0 + ai * HALF + m * 16) * ldc + col0 + bj * HALF) = pack8(o[0], o[1]);
                }
    }
};
struct EpiQKV {
    static constexpr bool PERM = true, AFTER_DRAIN = false;
    bf16_t* QKV; bf16_t* HALO; float* AB;
    __device__ __forceinline__ void operator()(const f32x4 (&acc)[2][2][4][2], const Unit& u, int wr, int wc, int fr, int fq) const {
        const int row0 = u.pm * BM + wr * 64 + fr;
        if (u.pn < 12) {
            const int col0 = u.pn * BM + wc * 32 + 8 * fq;
#pragma unroll
            for (int ai = 0; ai < 2; ++ai)
#pragma unroll
                for (int m = 0; m < 4; ++m) {
                    const int row = row0 + ai * HALF + m * 16;
#pragma unroll
                    for (int bj = 0; bj < 2; ++bj) {
                        const u32x4 w = pack8(acc[ai][bj][m][0], acc[ai][bj][m][1]);
                        *(u32x4*)(QKV + (size_t)row * 3072 + col0 + bj * HALF) = w;
                        if ((row & 63) >= 61) *(u32x4*)(HALO + (size_t)((row >> 6) * 3 + (row & 63) - 61) * 3072 + col0 + bj * HALF) = w;
                    }
                }
        } else if (wc == 0 && fq < 2) {
#pragma unroll
            for (int ai = 0; ai < 2; ++ai)
#pragma unroll
                for (int m = 0; m < 4; ++m) {
                    float* p = AB + (size_t)(row0 + ai * HALF + m * 16) * 16 + 8 * fq;
                    *(f32x4*)p = acc[ai][0][m][0]; *(f32x4*)(p + 4) = acc[ai][0][m][1];
                }
        }
    }
};
struct EpiZGG {
    static constexpr bool PERM = true, AFTER_DRAIN = false;
    bf16_t* Z; bf16_t* C; bf16_t* G;
    __device__ __forceinline__ void operator()(const f32x4 (&acc)[2][2][4][2], const Unit& u, int wr, int wc, int fr, int fq) const {
        if (u.pn < 4) { EpiAct<1> e{Z, 1024, 0}; e(acc, u, wr, wc, fr, fq); }
        else if (u.pn < 12) { EpiPair<1> e{C, 1024, 4}; e(acc, u, wr, wc, fr, fq); }
        else { EpiAct<2> e{G, 2048, 12}; e(acc, u, wr, wc, fr, fq); }
    }
};
struct EpiGate1 {
    static constexpr bool PERM = true, AFTER_DRAIN = false;
    const bf16_t* G; bf16_t* T;
    __device__ __forceinline__ void operator()(const f32x4 (&acc)[2][2][4][2], const Unit& u, int wr, int wc, int fr, int fq) const {
        const int row0 = u.pm * BM + wr * 64 + fr, col0 = u.pn * BM + wc * 32 + 8 * fq;
#pragma unroll
        for (int ai = 0; ai < 2; ++ai)
#pragma unroll
            for (int m = 0; m < 4; ++m)
#pragma unroll
                for (int bj = 0; bj < 2; ++bj) {
                    const size_t r = (size_t)(row0 + ai * HALF + m * 16); const int c = col0 + bj * HALF;
                    const u32x4 g = *(const u32x4*)(G + r * 2048 + c);
                    f32x4 a = acc[ai][bj][m][0], b = acc[ai][bj][m][1];
                    a[0] *= bf_lo(g.x); a[1] *= bf_hi(g.x); a[2] *= bf_lo(g.y); a[3] *= bf_hi(g.y); b[0] *= bf_lo(g.z); b[1] *= bf_hi(g.z); b[2] *= bf_lo(g.w); b[3] *= bf_hi(g.w);
                    *(u32x4*)(T + r * 1024 + c) = pack8(a, b);
                }
    }
};
struct EpiGate2 {
    static constexpr bool PERM = true, AFTER_DRAIN = false;
    const bf16_t* G; const bf16_t* T; const float* bias; bf16_t* Y;
    __device__ __forceinline__ void operator()(const f32x4 (&acc)[2][2][4][2], const Unit& u, int wr, int wc, int fr, int fq) const {
        const int row0 = u.pm * BM + wr * 64 + fr, col0 = u.pn * BM + wc * 32 + 8 * fq;
#pragma unroll
        for (int bj = 0; bj < 2; ++bj) {
            const int c = col0 + bj * HALF;
            const f32x4 b0 = *(const f32x4*)(bias + c), b1 = *(const f32x4*)(bias + c + 4);
#pragma unroll
            for (int ai = 0; ai < 2; ++ai)
#pragma unroll
                for (int m = 0; m < 4; ++m) {
                    const size_t r = (size_t)(row0 + ai * HALF + m * 16);
                    const u32x4 g = *(const u32x4*)(G + r * 2048 + 1024 + c), t = *(const u32x4*)(T + r * 1024 + c);
                    f32x4 a = acc[ai][bj][m][0] + b0, b = acc[ai][bj][m][1] + b1;
                    a[0] = bf_lo(t.x) + a[0] * bf_lo(g.x); a[1] = bf_hi(t.x) + a[1] * bf_hi(g.x); a[2] = bf_lo(t.y) + a[2] * bf_lo(g.y); a[3] = bf_hi(t.y) + a[3] * bf_hi(g.y);
                    b[0] = bf_lo(t.z) + b[0] * bf_lo(g.z); b[1] = bf_hi(t.z) + b[1] * bf_hi(g.z); b[2] = bf_lo(t.w) + b[2] * bf_lo(g.w); b[3] = bf_hi(t.w) + b[3] * bf_hi(g.w);
                    *(u32x4*)(Y + r * 1024 + c) = pack8(a, b);
                }
        }
    }
};
template <bool RES_BF16> struct EpiResid {
    static constexpr bool PERM = false, AFTER_DRAIN = false;
    const void* res; float* out; float alpha, s;
    __device__ __forceinline__ void operator()(const f32x4 (&acc)[2][2][4][2], const Unit& u, int wr, int wc, int fr, int fq) const {
        const int row0 = u.pm * BM + wr * 64 + fr, col0 = u.pn * BM + wc * 32 + 4 * fq;
#pragma unroll
        for (int ai = 0; ai < 2; ++ai)
#pragma unroll
            for (int m = 0; m < 4; ++m)
#pragma unroll
                for (int bj = 0; bj < 2; ++bj)
#pragma unroll
                    for (int n = 0; n < 2; ++n) {
                        const size_t off = (size_t)(row0 + ai * HALF + m * 16) * 1024 + col0 + bj * HALF + n * 16;
                        f32x4 r;
                        if (RES_BF16) { const u32x2 w = *(const u32x2*)((const bf16_t*)res + off); r = (f32x4){bf_lo(w.x), bf_hi(w.x), bf_lo(w.y), bf_hi(w.y)}; }
                        else r = *(const f32x4*)((const float*)res + off);
                        *(f32x4*)(out + off) = r * alpha + acc[ai][bj][m][n] * s;
                    }
    }
};
struct EpiPlainNP {
    static constexpr bool PERM = false, AFTER_DRAIN = false;
    bf16_t* O; int ldc; int mode;
    __device__ __forceinline__ void operator()(const f32x4 (&acc)[2][2][4][2], const Unit& u, int wr, int wc, int fr, int fq) const {
        int rb = u.pm * BM, cb = u.pn * BM;
        if (mode == 1) { const int L = u.tag; rb = (L >> 5) * 2048 + (L & 7) * 256; cb = ((L >> 3) & 3) * 256; }
        const int row0 = rb + wr * 64 + fr, col0 = cb + wc * 32 + 4 * fq;
#pragma unroll
        for (int ai = 0; ai < 2; ++ai)
#pragma unroll
            for (int m = 0; m < 4; ++m)
#pragma unroll
                for (int bj = 0; bj < 2; ++bj)
#pragma unroll
                    for (int n = 0; n < 2; ++n) {
                        const f32x4 v = acc[ai][bj][m][n]; u32x2 w; w.x = cvt_pk_bf16(v[0], v[1]); w.y = cvt_pk_bf16(v[2], v[3]);
                        *(u32x2*)(O + (size_t)(row0 + ai * HALF + m * 16) * ldc + col0 + bj * HALF + n * 16) = w;
                    }
    }
};
struct EpiKV {
    static constexpr bool PERM = false, AFTER_DRAIN = false;
    bf16_t* Kb; bf16_t* VT;
    __device__ __forceinline__ void operator()(const f32x4 (&acc)[2][2][4][2], const Unit& u, int wr, int wc, int fr, int fq) const {
        if (u.pn < 4) { EpiPlainNP e{Kb, 1024, 0}; e(acc, u, wr, wc, fr, fq); return; }
        const int h = u.pn - 4, b = u.pm; bf16_t* base = VT + (size_t)(b * 4 + h) * 65536;
#pragma unroll
        for (int ai = 0; ai < 2; ++ai)
#pragma unroll
            for (int m = 0; m < 4; ++m) {
                const int mem = ai * HALF + wr * 64 + m * 16 + fr;
#pragma unroll
                for (int bj = 0; bj < 2; ++bj)
#pragma unroll
                    for (int n = 0; n < 2; ++n) {
                        const f32x4 v = acc[ai][bj][m][n]; const int hd = bj * HALF + wc * 32 + n * 16 + 4 * fq;
                        const unsigned w0 = cvt_pk_bf16(v[0], v[1]), w1 = cvt_pk_bf16(v[2], v[3]);
                        base[(size_t)(hd + 0) * 256 + mem] = (bf16_t)(w0 & 0xffffu); base[(size_t)(hd + 1) * 256 + mem] = (bf16_t)(w0 >> 16);
                        base[(size_t)(hd + 2) * 256 + mem] = (bf16_t)(w1 & 0xffffu); base[(size_t)(hd + 3) * 256 + mem] = (bf16_t)(w1 >> 16);
                    }
            }
    }
};
struct EpiSoftmax {
    static constexpr bool PERM = false, AFTER_DRAIN = true;
    bf16_t* P; float scale;
    __device__ __forceinline__ void fused(f32x4 (&acc)[2][2][4][2], const Unit& u, int wr, int wc, int fr, int fq, PG8_LAS unsigned char* lds, int wid, int lane) const {
        PG8_LAS float* PM = (PG8_LAS float*)lds;
        PG8_LAS float* PS = (PG8_LAS float*)(lds + 4096);
        const float sc = scale * 1.4426950408889634f;
#pragma unroll
        for (int ai = 0; ai < 2; ++ai)
#pragma unroll
            for (int m = 0; m < 4; ++m) {
                float mx = -3.0e38f;
#pragma unroll
                for (int bj = 0; bj < 2; ++bj)
#pragma unroll
                    for (int n = 0; n < 2; ++n) { f32x4 v = acc[ai][bj][m][n] * sc; acc[ai][bj][m][n] = v; mx = fmaxf(mx, fmaxf(fmaxf(v[0], v[1]), fmaxf(v[2], v[3]))); }
                mx = fmaxf(mx, __shfl_xor(mx, 16)); mx = fmaxf(mx, __shfl_xor(mx, 32));
                if (fq == 0) PM[(ai * HALF + wr * 64 + m * 16 + fr) * 4 + wc] = mx;
            }
        asm volatile("s_waitcnt lgkmcnt(0)" ::: "memory"); __builtin_amdgcn_s_barrier(); asm volatile("" ::: "memory");
#pragma unroll
        for (int ai = 0; ai < 2; ++ai)
#pragma unroll
            for (int m = 0; m < 4; ++m) {
                const int r = ai * HALF + wr * 64 + m * 16 + fr;
                const f32x4 pm = *(const PG8_LAS f32x4*)(PM + r * 4);
                const float mx = fmaxf(fmaxf(pm[0], pm[1]), fmaxf(pm[2], pm[3]));
                float s = 0.f;
#pragma unroll
                for (int bj = 0; bj < 2; ++bj)
#pragma unroll
                    for (int n = 0; n < 2; ++n) { f32x4 v = acc[ai][bj][m][n]; v[0] = __builtin_amdgcn_exp2f(v[0] - mx); v[1] = __builtin_amdgcn_exp2f(v[1] - mx); v[2] = __builtin_amdgcn_exp2f(v[2] - mx); v[3] = __builtin_amdgcn_exp2f(v[3] - mx);
                        acc[ai][bj][m][n] = v; s += (v[0] + v[1]) + (v[2] + v[3]); }
                s += __shfl_xor(s, 16); s += __shfl_xor(s, 32);
                if (fq == 0) PS[r * 4 + wc] = s;
            }
        asm volatile("s_waitcnt lgkmcnt(0)" ::: "memory"); __builtin_amdgcn_s_barrier(); asm volatile("" ::: "memory");
        const int L = u.tag;
#pragma unroll
        for (int ai = 0; ai < 2; ++ai)
#pragma unroll
            for (int m = 0; m < 4; ++m) {
                const int r = ai * HALF + wr * 64 + m * 16 + fr;
                const f32x4 ps = *(const PG8_LAS f32x4*)(PS + r * 4);
                const float inv = 1.0f / ((ps[0] + ps[1]) + (ps[2] + ps[3]));
#pragma unroll
                for (int bj = 0; bj < 2; ++bj)
#pragma unroll
                    for (int n = 0; n < 2; ++n) { const f32x4 v = acc[ai][bj][m][n] * inv; u32x2 w; w.x = cvt_pk_bf16(v[0], v[1]); w.y = cvt_pk_bf16(v[2], v[3]);
                        *(u32x2*)(P + ((size_t)L * 256 + r) * 256 + bj * HALF + wc * 32 + n * 16 + 4 * fq) = w; }
            }
        asm volatile("s_waitcnt lgkmcnt(0)" ::: "memory"); __builtin_amdgcn_s_barrier(); asm volatile("" ::: "memory");
    }
};

template <class Epi, class Sched, bool ALIGN_EPI = false, bool SP2 = false>
__device__ __forceinline__ void gemm_phase(PG8_LAS unsigned char* lds, const Gemm g, const Sched& S, const Epi& E) {
    const int tid = threadIdx.x, wid = __builtin_amdgcn_readfirstlane(tid >> 6), lane = tid & 63, wr = wid >> 2, wc = wid & 3, fr = lane & 15, fq = lane >> 4;
    const int K = g.K, nt = K / BK;
    unsigned voffA[2], voffB[2];
#pragma unroll
    for (int i = 0; i < 2; ++i) { int R, C; stage_rc(tid * 16 + i * 8192, R, C); const int Rb = Epi::PERM ? ((R & ~31) + perm32(R & 31)) : R;
        voffA[i] = (unsigned)(R * g.lda + C) * 2u; voffB[i] = (unsigned)(Rb * g.ldb + C) * 2u; }
    const size_t kstep = (size_t)(BK * 2);
    const size_t hstepA = (size_t)HALF * g.lda * 2, hstepB = (size_t)HALF * g.ldb * 2;
    const size_t tstepA = 2 * hstepA, tstepB = 2 * hstepB;
    const unsigned ldsw = (unsigned)wid * 1024u;
    const int aoff = lds_byte(wr * 64 + fr, fq * 8), boff = lds_byte(wc * 32 + fr, fq * 8);
#define PG8_SA(b, h) (((b) * 2 + (h)) * HTB)
#define PG8_SB(b, h) ((4 + (b) * 2 + (h)) * HTB)
#define PG8_STAGE(bufoff, gbase, voff) do { _Pragma("unroll") for (int _i = 0; _i < 2; ++_i) \
        __builtin_amdgcn_global_load_lds((const unsigned*)((const char*)(gbase) + (voff)[_i]), (PG8_LAS unsigned*)(lds + (bufoff) + ldsw + _i * 8192), 16, 0, 0); } while (0)
#define PG8_LDA(dst, b, h) do { _Pragma("unroll") for (int m = 0; m < 4; ++m) _Pragma("unroll") for (int k = 0; k < 2; ++k) dst[m][k] = *(const PG8_LAS bf16x8*)(lds + PG8_SA(b, h) + aoff + m * 2048 + k * 1024); } while (0)
#define PG8_LDB(dst, b, h) do { _Pragma("unroll") for (int n = 0; n < 2; ++n) _Pragma("unroll") for (int k = 0; k < 2; ++k) dst[n][k] = *(const PG8_LAS bf16x8*)(lds + PG8_SB(b, h) + boff + n * 2048 + k * 1024); } while (0)
#define PG8_MMA(ai, bj, At, Bt) do { __builtin_amdgcn_s_setprio(1); _Pragma("unroll") for (int m = 0; m < 4; ++m) _Pragma("unroll") for (int n = 0; n < 2; ++n) _Pragma("unroll") for (int k = 0; k < 2; ++k) \
        acc[ai][bj][m][n] = __builtin_amdgcn_mfma_f32_16x16x32_bf16(Bt[n][k], At[m][k], acc[ai][bj][m][n], 0, 0, 0); __builtin_amdgcn_s_setprio(0); } while (0)
#define PG8_WAIT_V(n) asm volatile("s_waitcnt vmcnt(" #n ")" ::: "memory")
#define PG8_WAIT_L(n) asm volatile("s_waitcnt lgkmcnt(" #n ")" ::: "memory")
#define PG8_BAR __builtin_amdgcn_s_barrier()
#define PG8_SCHED __builtin_amdgcn_sched_barrier(0)
    Unit cur, nxt; int ui = 0;
    if (!S.next(0, cur)) return;
    f32x4 acc[2][2][4][2];
#pragma unroll
    for (int a = 0; a < 2; ++a)
#pragma unroll
        for (int b = 0; b < 2; ++b)
#pragma unroll
            for (int m = 0; m < 4; ++m)
#pragma unroll
                for (int n = 0; n < 2; ++n) acc[a][b][m][n] = (f32x4){0.f, 0.f, 0.f, 0.f};
    bf16x8 At[4][2], B0[2][2], B1[2][2];
    const char* cA = (const char*)g.A + (size_t)cur.pm * tstepA + cur.aoff; const char* cB = (const char*)g.Bt + (size_t)cur.pn * tstepB + cur.boff;
    S.a_ready(cur);
    if constexpr (SP2) {
        PG8_STAGE(PG8_SB(0, 0), cB, voffB); PG8_STAGE(PG8_SB(0, 1), cB + hstepB, voffB); PG8_STAGE(PG8_SA(0, 0), cA, voffA); PG8_STAGE(PG8_SA(0, 1), cA + hstepA, voffA);
        if (wr == 1) PG8_BAR;
        PG8_WAIT_V(2); PG8_BAR;
        PG8_STAGE(PG8_SB(1, 0), cB + kstep, voffB); PG8_STAGE(PG8_SA(1, 0), cA + kstep, voffA); PG8_STAGE(PG8_SB(1, 1), cB + hstepB + kstep, voffB);
        PG8_WAIT_V(6); PG8_BAR;
    } else {
        PG8_STAGE(PG8_SB(0, 0), cB, voffB); PG8_STAGE(PG8_SA(0, 0), cA, voffA); PG8_STAGE(PG8_SB(0, 1), cB + hstepB, voffB); PG8_STAGE(PG8_SA(0, 1), cA + hstepA, voffA);
        if (wr == 1) PG8_BAR;
        PG8_WAIT_V(4); PG8_BAR;
        PG8_STAGE(PG8_SB(1, 0), cB + kstep, voffB); PG8_STAGE(PG8_SA(1, 0), cA + kstep, voffA); PG8_STAGE(PG8_SB(1, 1), cB + hstepB + kstep, voffB);
        PG8_WAIT_V(6); PG8_BAR;
    }
    for (;;) {
        const bool has_next = S.next(ui + 1, nxt);
        const char* nA = has_next ? (const char*)g.A + (size_t)nxt.pm * tstepA + nxt.aoff : cA; const char* nB = has_next ? (const char*)g.Bt + (size_t)nxt.pn * tstepB + nxt.boff : cB;
        for (int t = 0; t < nt; t += 2) {
            const bool last = (t == nt - 2);
            const char* a1 = cA + (size_t)(t + 1) * kstep;
            const char* a2 = last ? nA : cA + (size_t)(t + 2) * kstep; const char* b2 = last ? nB : cB + (size_t)(t + 2) * kstep;
            const char* a3 = a2 + kstep; const char* b3 = b2 + kstep;
            if (last && has_next) S.a_ready(nxt);
            if constexpr (SP2) {
            PG8_LDB(B0, 0, 0); PG8_LDB(B1, 0, 1); PG8_SCHED; PG8_LDA(At, 0, 0); PG8_STAGE(PG8_SA(1, 1), a1 + hstepA, voffA);
            PG8_WAIT_V(8); PG8_WAIT_L(0); PG8_BAR; PG8_MMA(0, 0, At, B0); PG8_MMA(0, 1, At, B1); PG8_BAR; PG8_SCHED;
            PG8_LDA(At, 0, 1); PG8_STAGE(PG8_SB(0, 0), b2, voffB); PG8_STAGE(PG8_SB(0, 1), b2 + hstepB, voffB); PG8_STAGE(PG8_SA(0, 0), a2, voffA);
            PG8_WAIT_V(8); PG8_WAIT_L(0); PG8_BAR; PG8_MMA(1, 0, At, B0); PG8_MMA(1, 1, At, B1); PG8_BAR; PG8_SCHED;
            PG8_LDB(B0, 1, 0); PG8_LDB(B1, 1, 1); PG8_SCHED; PG8_LDA(At, 1, 0); PG8_STAGE(PG8_SA(0, 1), a2 + hstepA, voffA);
            PG8_WAIT_V(8); PG8_WAIT_L(0); PG8_BAR; PG8_MMA(0, 0, At, B0); PG8_MMA(0, 1, At, B1); PG8_BAR; PG8_SCHED;
            PG8_LDA(At, 1, 1); PG8_STAGE(PG8_SB(1, 0), b3, voffB); PG8_STAGE(PG8_SB(1, 1), b3 + hstepB, voffB); PG8_STAGE(PG8_SA(1, 0), a3, voffA);
            PG8_WAIT_V(8); PG8_WAIT_L(0); PG8_BAR; PG8_MMA(1, 0, At, B0); PG8_MMA(1, 1, At, B1); PG8_BAR; PG8_SCHED;
            } else {
            PG8_LDB(B0, 0, 0); PG8_SCHED; PG8_LDA(At, 0, 0); PG8_STAGE(PG8_SA(1, 1), a1 + hstepA, voffA);
            PG8_WAIT_L(8); PG8_BAR; PG8_WAIT_L(0); PG8_MMA(0, 0, At, B0); PG8_BAR; PG8_SCHED;
            PG8_LDB(B1, 0, 1); PG8_STAGE(PG8_SB(0, 0), b2, voffB);
            PG8_BAR; PG8_WAIT_L(0); PG8_MMA(0, 1, At, B1); PG8_BAR;
            PG8_LDA(At, 0, 1); PG8_STAGE(PG8_SA(0, 0), a2, voffA);
            PG8_BAR; PG8_WAIT_L(0); PG8_MMA(1, 0, At, B0); PG8_BAR; PG8_SCHED;
            PG8_STAGE(PG8_SB(0, 1), b2 + hstepB, voffB);
            PG8_WAIT_V(6); PG8_BAR; PG8_MMA(1, 1, At, B1); PG8_BAR;
            PG8_LDB(B0, 1, 0); PG8_SCHED; PG8_LDA(At, 1, 0); PG8_STAGE(PG8_SA(0, 1), a2 + hstepA, voffA);
            PG8_WAIT_L(8); PG8_BAR; PG8_WAIT_L(0); PG8_MMA(0, 0, At, B0); PG8_BAR; PG8_SCHED;
            PG8_LDB(B1, 1, 1); PG8_STAGE(PG8_SB(1, 0), b3, voffB);
            PG8_BAR; PG8_WAIT_L(0); PG8_MMA(0, 1, At, B1); PG8_BAR;
            PG8_LDA(At, 1, 1); PG8_STAGE(PG8_SA(1, 0), a3, voffA);
            PG8_BAR; PG8_WAIT_L(0); PG8_MMA(1, 0, At, B0); PG8_BAR; PG8_SCHED;
            PG8_STAGE(PG8_SB(1, 1), b3 + hstepB, voffB);
            PG8_WAIT_V(6); PG8_BAR; PG8_MMA(1, 1, At, B1); PG8_BAR;
            }
        }
        if constexpr (ALIGN_EPI) { if (wr == 0) PG8_BAR; }
        if constexpr (!Epi::AFTER_DRAIN) { E(acc, cur, wr, wc, fr, fq); S.done(cur); }
        if (!has_next) break;
#pragma unroll
        for (int a = 0; a < 2; ++a)
#pragma unroll
            for (int b = 0; b < 2; ++b)
#pragma unroll
                for (int m = 0; m < 4; ++m)
#pragma unroll
                    for (int n = 0; n < 2; ++n) acc[a][b][m][n] = (f32x4){0.f, 0.f, 0.f, 0.f};
        cur = nxt; cA = nA; cB = nB; ++ui;
        if constexpr (ALIGN_EPI) { if (wr == 1) PG8_BAR; }
    }
    PG8_WAIT_V(0);
    if constexpr (!ALIGN_EPI) { if (wr == 0) PG8_BAR; }
    PG8_BAR;
    if constexpr (Epi::AFTER_DRAIN) { E.fused(acc, cur, wr, wc, fr, fq, lds, wid, lane); S.done(cur); }
#undef PG8_SA
#undef PG8_SB
#undef PG8_STAGE
#undef PG8_LDA
#undef PG8_LDB
#undef PG8_MMA
#undef PG8_WAIT_V
#undef PG8_WAIT_L
#undef PG8_BAR
#undef PG8_SCHED
}
}

using pg8::bf16_t; using pg8::f32x4; using pg8::u32x4; using pg8::u32x2; using pg8::bf16x8;
#define LAS __attribute__((address_space(3)))

constexpr int DM = 1024, NB = 8, SEQ = 2048, M = NB * SEQ, DFF = 2816, NMEM = 256, NH = 8, DK = 128, CW = 31;
constexpr float ALPHA = 1.189207115002721f, LN_EPS = 1e-5f, RMS_EPS = 1e-6f;
constexpr int NWAVES = 8, NTHR = 512;
constexpr int LDS_BYTES = 147456;

constexpr size_t MiB = 1u << 20;
constexpr size_t W_GU1 = 0, W_D1 = 11 * MiB, W_GU2 = 16 * MiB + MiB / 2, W_D2 = 27 * MiB + MiB / 2, W_INA = 33 * MiB, W_INB = 39 * MiB + MiB / 2,
                 W_GDN = 49 * MiB + MiB / 2, W_CONV = 51 * MiB + MiB / 2, W_MIX = 53 * MiB + MiB / 2, W_XQ = 55 * MiB + MiB / 2, W_XO = 57 * MiB + MiB / 2, W_XKV = 59 * MiB + MiB / 2;
constexpr size_t WS_CTL = 63 * MiB + MiB / 2 + 4096;
constexpr size_t WS_XB = 64 * MiB, WS_K = 96 * MiB, WS_VT = 100 * MiB, WS_R = 104 * MiB;
constexpr size_t WS_H = WS_R;
constexpr size_t WS_MEMB = 248 * MiB;
constexpr size_t WS_QKV = WS_R, WS_KT = 200 * MiB, WS_AQK = 232 * MiB, WS_HALO = 248 * MiB, WS_EGC = 253 * MiB, WS_AB = 254 * MiB;
constexpr size_t WS_C = WS_R, WS_G = 136 * MiB, WS_CC = 200 * MiB, WS_YMIX = WS_R;
constexpr size_t WS_Q = WS_R, WS_P = 136 * MiB, WS_O = 168 * MiB;

struct Args { const float* in[32]; float* out; unsigned char* ws; int ph_lo, ph_hi; };

struct Seg { int in, K, N, col0, ncols, row0, type; unsigned long long dst; };
__constant__ Seg c_seg[18] = {
    {2, 1024, 2816, 0, 2816, 0, 1, W_GU1}, {3, 1024, 2816, 0, 2816, 128, 1, W_GU1}, {4, 2816, 1024, 0, 1024, 0, 0, W_D1},
    {27, 1024, 2816, 0, 2816, 0, 1, W_GU2}, {28, 1024, 2816, 0, 2816, 128, 1, W_GU2}, {29, 2816, 1024, 0, 1024, 0, 0, W_D2},
    {7, 1024, 8208, 0, 3072, 0, 0, W_INA}, {7, 1024, 8208, 4096, 32, 3072, 0, W_INA},
    {7, 1024, 8208, 3072, 1024, 0, 0, W_INB}, {7, 1024, 8208, 4112, 1024, 1024, 1, W_INB}, {7, 1024, 8208, 5136, 1024, 1152, 1, W_INB}, {7, 1024, 8208, 6160, 2048, 3072, 0, W_INB},
    {12, 1024, 1024, 0, 1024, 0, 0, W_GDN}, {17, 1024, 1024, 0, 1024, 0, 0, W_CONV}, {19, 1024, 1024, 0, 1024, 0, 0, W_MIX}, {22, 1024, 1024, 0, 1024, 0, 0, W_XQ}, {24, 1024, 1024, 0, 1024, 0, 0, W_XO},
    {23, 1024, 2048, 0, 2048, 0, 0, W_XKV}};

__device__ __forceinline__ float wave_sum(float v) {
#pragma unroll
    for (int o = 1; o < 64; o <<= 1) v += __shfl_xor(v, o);
    return v;
}
__device__ __forceinline__ unsigned pk2(float lo, float hi) { return pg8::cvt_pk_bf16(lo, hi); }
__device__ __forceinline__ float bflo(unsigned w) { return __uint_as_float(w << 16); }
__device__ __forceinline__ float bfhi(unsigned w) { return __uint_as_float(w & 0xffff0000u); }
__device__ __forceinline__ float bf1(bf16_t h) { return __uint_as_float(((unsigned)h) << 16); }
__device__ __forceinline__ bf16_t tobf(float f) { return (bf16_t)(pg8::cvt_pk_bf16(f, 0.f) & 0xffffu); }

__device__ __forceinline__ void p0_item(const float* W, int K, int N, int col0, bf16_t* WT, int row0, int type, LAS float* scr, int item, int ncols, int lane) {
    const int nblk = ncols / 32, kb = item / nblk, nb = item % nblk, k0 = 64 * kb, n0 = 32 * nb;
#pragma unroll 8
    for (int i = 0; i < 32; ++i) { const int kk = 2 * i + (lane >> 5); scr[kk * 33 + (lane & 31)] = W[(size_t)(k0 + kk) * N + col0 + n0 + (lane & 31)]; }
    asm volatile("s_waitcnt lgkmcnt(0)" ::: "memory");
    const int c = lane & 7;
#pragma unroll
    for (int j = 0; j < 4; ++j) { const int n = (lane >> 3) + 8 * j; const LAS float* s = scr + (8 * c) * 33 + n;
        u32x4 o; o.x = pk2(s[0 * 33], s[1 * 33]); o.y = pk2(s[2 * 33], s[3 * 33]); o.z = pk2(s[4 * 33], s[5 * 33]); o.w = pk2(s[6 * 33], s[7 * 33]);
        const int nn = n0 + n; const int drow = type ? row0 + 256 * (nn >> 7) + (nn & 127) : row0 + nn;
        *(u32x4*)(WT + (size_t)drow * K + k0 + 8 * c) = o; }
    asm volatile("s_waitcnt lgkmcnt(0)" ::: "memory");
}
__device__ __forceinline__ void phase_prologue(const Args& a, LAS unsigned char* lds, int gw, int NGW, int wave, int lane) {
    LAS float* scr = (LAS float*)(lds + wave * 16384);
    int total = 0;
#pragma unroll 1
    for (int s = 0; s < 18; ++s) total += (c_seg[s].K / 64) * (c_seg[s].ncols / 32);
    for (int it = gw; it < total; it += NGW) {
        int r = it, s = 0;
        for (;; ++s) { const int cnt = (c_seg[s].K / 64) * (c_seg[s].ncols / 32); if (r < cnt) break; r -= cnt; }
        p0_item(a.in[c_seg[s].in], c_seg[s].K, c_seg[s].N, c_seg[s].col0, (bf16_t*)(a.ws + c_seg[s].dst), c_seg[s].row0, c_seg[s].type, scr, r, c_seg[s].ncols, lane);
    }
    { u32x4* z = (u32x4*)(a.ws + W_INA + (size_t)3104 * 1024 * 2); for (int i = gw * 64 + lane; i < 458752 / 16; i += NGW * 64) z[i] = (u32x4){0u, 0u, 0u, 0u}; }
    { const f32x4* x = (const f32x4*)a.in[0]; u32x4* o = (u32x4*)(a.ws + WS_XB);
      for (int i = gw * 64 + lane; i < M * DM / 8; i += NGW * 64) { const f32x4 v0 = x[2 * i], v1 = x[2 * i + 1]; o[i] = pg8::pack8(v0, v1); } }
    { const f32x4* x = (const f32x4*)a.in[1]; u32x4* o = (u32x4*)(a.ws + WS_MEMB);
      for (int i = gw * 64 + lane; i < NB * NMEM * DM / 8; i += NGW * 64) { const f32x4 v0 = x[2 * i], v1 = x[2 * i + 1]; o[i] = pg8::pack8(v0, v1); } }
}

__device__ __forceinline__ void phase_ln(const float* src, float* dstf, bf16_t* dstb, const float* g, const float* b, int gw, int NGW, int lane) {
    f32x4 gg[4], bb[4];
#pragma unroll
    for (int j = 0; j < 4; ++j) { gg[j] = ((const f32x4*)g)[lane + 64 * j]; bb[j] = ((const f32x4*)b)[lane + 64 * j]; }
    for (int m = gw; m < M; m += NGW) {
        const f32x4* xr = (const f32x4*)(src + (size_t)m * DM) + lane;
        f32x4 v[4]; float s = 0.f;
#pragma unroll
        for (int j = 0; j < 4; ++j) { v[j] = xr[64 * j]; s += (v[j][0] + v[j][1]) + (v[j][2] + v[j][3]); }
        const float mean = wave_sum(s) * (1.f / DM); float s2 = 0.f;
#pragma unroll
        for (int j = 0; j < 4; ++j) { v[j] = v[j] - mean; s2 += (v[j][0] * v[j][0] + v[j][1] * v[j][1]) + (v[j][2] * v[j][2] + v[j][3] * v[j][3]); }
        const float rstd = 1.f / sqrtf(wave_sum(s2) * (1.f / DM) + LN_EPS);
#pragma unroll
        for (int j = 0; j < 4; ++j) { v[j] = v[j] * rstd * gg[j] + bb[j]; }
        if (dstf) {
            f32x4* o = (f32x4*)(dstf + (size_t)m * DM) + lane;
#pragma unroll
            for (int j = 0; j < 4; ++j) o[64 * j] = v[j];
        }
        if (dstb) {
            u32x2* o = (u32x2*)(dstb + (size_t)m * DM) + lane;
#pragma unroll
            for (int j = 0; j < 4; ++j) { u32x2 w; w.x = pk2(v[j][0], v[j][1]); w.y = pk2(v[j][2], v[j][3]); o[64 * j] = w; }
        }
    }
}

__device__ __forceinline__ void phase_conv31(const bf16_t* C, bf16_t* CC, const float* w, const float* bias, const float* lg, const float* lb, LAS unsigned char* lds, int G, int tid) {
    LAS float* tile = (LAS float*)lds;
    const int wave = tid >> 6, lane = tid & 63;
    float w0[CW], w1[CW];
#pragma unroll
    for (int j = 0; j < CW; ++j) { const float2 t = *(const float2*)(w + (size_t)j * DM + 2 * tid); w0[j] = t.x; w1[j] = t.y; }
    const float2 bs = *(const float2*)(bias + 2 * tid);
    f32x4 gg[4], bb[4];
#pragma unroll
    for (int j = 0; j < 4; ++j) { gg[j] = ((const f32x4*)lg)[lane + 64 * j]; bb[j] = ((const f32x4*)lb)[lane + 64 * j]; }
    for (int it = blockIdx.x; it < M / 8; it += G) {
        const int t0 = it * 8, s0 = t0 & (SEQ - 1);
        float a0[8], a1[8];
#pragma unroll
        for (int o = 0; o < 8; ++o) { a0[o] = bs.x; a1[o] = bs.y; }
#pragma unroll
        for (int r = -(CW - 1); r < 8; ++r) {
            unsigned xw = 0u;
            if (s0 + r >= 0) xw = *(const unsigned*)(C + (size_t)(t0 + r) * DM + 2 * tid);
            const float x0 = bflo(xw), x1 = bfhi(xw);
#pragma unroll
            for (int o = 0; o < 8; ++o) { const int j = r - o + (CW - 1); if (j >= 0 && j < CW) { a0[o] += x0 * w0[j]; a1[o] += x1 * w1[j]; } }
        }
#pragma unroll
        for (int o = 0; o < 8; ++o) *(LAS pg8::f32x2*)(tile + o * DM + 2 * tid) = (pg8::f32x2){a0[o], a1[o]};
        __syncthreads();
        {
            const LAS f32x4* xr = (const LAS f32x4*)(tile + wave * DM) + lane;
            f32x4 v[4]; float s = 0.f;
#pragma unroll
            for (int j = 0; j < 4; ++j) { v[j] = xr[64 * j]; s += (v[j][0] + v[j][1]) + (v[j][2] + v[j][3]); }
            const float mean = wave_sum(s) * (1.f / DM); float s2 = 0.f;
#pragma unroll
            for (int j = 0; j < 4; ++j) { v[j] = v[j] - mean; s2 += (v[j][0] * v[j][0] + v[j][1] * v[j][1]) + (v[j][2] * v[j][2] + v[j][3] * v[j][3]); }
            const float rstd = 1.f / sqrtf(wave_sum(s2) * (1.f / DM) + LN_EPS);
            u32x2* o = (u32x2*)(CC + (size_t)(t0 + wave) * DM) + lane;
#pragma unroll
            for (int j = 0; j < 4; ++j) { f32x4 y = v[j] * rstd * gg[j] + bb[j]; u32x2 ww; ww.x = pk2(pg8::silu(y[0]), pg8::silu(y[1])); ww.y = pk2(pg8::silu(y[2]), pg8::silu(y[3])); o[64 * j] = ww; }
        }
        __syncthreads();
    }
}

__device__ __forceinline__ void phase_gate_rms(bf16_t* O, const bf16_t* Z, const float* gn, int gw, int NGW, int lane) {
    f32x4 g4[4];
#pragma unroll
    for (int j = 0; j < 4; ++j) g4[j] = ((const f32x4*)gn)[(lane & 7) * 4 + j];
    for (int m = gw; m < M; m += NGW) {
        u32x4* op = (u32x4*)(O + (size_t)m * DM) + 2 * lane; const u32x4* zp = (const u32x4*)(Z + (size_t)m * DM) + 2 * lane;
        const u32x4 o0 = op[0], o1 = op[1], z0 = zp[0], z1 = zp[1];
        float v[16] = {bflo(o0.x), bfhi(o0.x), bflo(o0.y), bfhi(o0.y), bflo(o0.z), bfhi(o0.z), bflo(o0.w), bfhi(o0.w), bflo(o1.x), bfhi(o1.x), bflo(o1.y), bfhi(o1.y), bflo(o1.z), bfhi(o1.z), bflo(o1.w), bfhi(o1.w)};
        float zz[16] = {bflo(z0.x), bfhi(z0.x), bflo(z0.y), bfhi(z0.y), bflo(z0.z), bfhi(z0.z), bflo(z0.w), bfhi(z0.w), bflo(z1.x), bfhi(z1.x), bflo(z1.y), bfhi(z1.y), bflo(z1.z), bfhi(z1.z), bflo(z1.w), bfhi(z1.w)};
        float ss = 0.f;
#pragma unroll
        for (int i = 0; i < 16; ++i) ss += v[i] * v[i];
        ss += __shfl_xor(ss, 1); ss += __shfl_xor(ss, 2); ss += __shfl_xor(ss, 4);
        const float rstd = 1.f / sqrtf(ss * (1.f / 128.f) + RMS_EPS);
#pragma unroll
        for (int i = 0; i < 16; ++i) v[i] = v[i] * rstd * g4[i >> 2][i & 3] * zz[i];
        u32x4 r0, r1; r0.x = pk2(v[0], v[1]); r0.y = pk2(v[2], v[3]); r0.z = pk2(v[4], v[5]); r0.w = pk2(v[6], v[7]); r1.x = pk2(v[8], v[9]); r1.y = pk2(v[10], v[11]); r1.z = pk2(v[12], v[13]); r1.w = pk2(v[14], v[15]);
        op[0] = r0; op[1] = r1;
    }
}

constexpr int PREP_HALF = 4 * 17408 + 1024;
static_assert(2 * PREP_HALF <= LDS_BYTES, "prep LDS");
__device__ __forceinline__ void phase_gdn_prep(const Args& a, LAS unsigned char* lds, int G, int tid) {
    bf16_t* QKV = (bf16_t*)(a.ws + WS_QKV); const bf16_t* HALO = (const bf16_t*)(a.ws + WS_HALO); const float* AB = (const float*)(a.ws + WS_AB);
    bf16_t* KT = (bf16_t*)(a.ws + WS_KT); bf16_t* AQK = (bf16_t*)(a.ws + WS_AQK); float* EGC = (float*)(a.ws + WS_EGC);
    const float* convw = a.in[8]; const float* a_log = a.in[9]; const float* dt_bias = a.in[10];
    const int hw = tid >> 8, t = tid & 255, wv = (tid >> 6) & 3, lane = tid & 63;
    LAS unsigned char* base = lds + hw * PREP_HALF;
    LAS bf16_t* Kb = (LAS bf16_t*)base; LAS bf16_t* Qb = (LAS bf16_t*)(base + 17408); LAS bf16_t* Vb = (LAS bf16_t*)(base + 2 * 17408);
    LAS float* Mf = (LAS float*)(base + 3 * 17408); LAS float* gcs = (LAS float*)(base + 4 * 17408); LAS float* betas = gcs + 64;
    for (int it = blockIdx.x; it < 1024; it += G) {
        const int ch = it * 2 + hw, b = ch >> 8, h = (ch >> 5) & 7, n = ch & 31;
        const int row0 = b * SEQ + n * 64;
        if (wv == 0) {
            const float av = AB[(size_t)(row0 + lane) * 16 + h], bv = AB[(size_t)(row0 + lane) * 16 + 8 + h];
            const float xx = av + dt_bias[h];
            const float sp = xx > 20.f ? xx : log1pf(expf(xx));
            float g = -expf(a_log[h]) * sp;
#pragma unroll
            for (int o = 1; o < 64; o <<= 1) { const float up = __shfl_up(g, o); if (lane >= o) g += up; }
            gcs[lane] = g; betas[lane] = pg8::sigm(bv);
        }
        {
            const int cgp = t & 15, rb = t >> 4;
#pragma unroll 1
            for (int ten = 0; ten < 3; ++ten) {
                const int colb = ten * 1024 + h * 128 + cgp * 8;
                f32x4 w[4][2];
#pragma unroll
                for (int j = 0; j < 4; ++j) { w[j][0] = *(const f32x4*)(convw + (size_t)j * 3072 + colb); w[j][1] = *(const f32x4*)(convw + (size_t)j * 3072 + colb + 4); }
#pragma unroll
                for (int i4 = 0; i4 < 4; ++i4) {
                    const int c = rb + 16 * i4;
                    float o[8] = {0.f, 0.f, 0.f, 0.f, 0.f, 0.f, 0.f, 0.f};
#pragma unroll
                    for (int j = 0; j < 4; ++j) {
                        const int rr = c - 3 + j; u32x4 x = (u32x4){0u, 0u, 0u, 0u};
                        if (rr >= 0) x = *(const u32x4*)(QKV + (size_t)(row0 + rr) * 3072 + colb);
                        else if (n > 0) x = *(const u32x4*)(HALO + (size_t)((b * 32 + n - 1) * 3 + 3 + rr) * 3072 + colb);
                        o[0] += bflo(x.x) * w[j][0][0]; o[1] += bfhi(x.x) * w[j][0][1]; o[2] += bflo(x.y) * w[j][0][2]; o[3] += bfhi(x.y) * w[j][0][3];
                        o[4] += bflo(x.z) * w[j][1][0]; o[5] += bfhi(x.z) * w[j][1][1]; o[6] += bflo(x.w) * w[j][1][2]; o[7] += bfhi(x.w) * w[j][1][3];
                    }
                    float ss = 0.f;
#pragma unroll
                    for (int i = 0; i < 8; ++i) { o[i] = pg8::silu(o[i]); ss += o[i] * o[i]; }
                    if (ten < 2) {
                        ss += __shfl_xor(ss, 1); ss += __shfl_xor(ss, 2); ss += __shfl_xor(ss, 4); ss += __shfl_xor(ss, 8);
                        const float sc = (1.f / sqrtf(ss + RMS_EPS)) * (ten == 0 ? 0.08838834764831845f : 1.f);
#pragma unroll
                        for (int i = 0; i < 8; ++i) o[i] *= sc;
                    }
                    u32x4 pk; pk.x = pk2(o[0], o[1]); pk.y = pk2(o[2], o[3]); pk.z = pk2(o[4], o[5]); pk.w = pk2(o[6], o[7]);
                    LAS bf16_t* dst = (ten == 0 ? Qb : (ten == 1 ? Kb : Vb)) + c * 136 + cgp * 8;
                    *(LAS u32x4*)dst = pk;
                }
            }
        }
        __syncthreads();
#pragma unroll
        for (int i4 = 0; i4 < 4; ++i4) { const int c = (t >> 4) + 16 * i4, cgp = t & 15;
            *(u32x4*)(QKV + (size_t)(row0 + c) * 3072 + h * 128 + cgp * 8) = *(const LAS u32x4*)(Qb + c * 136 + cgp * 8); }
        {
            const int ct = wv, l15 = lane & 15, q4 = lane >> 4;
            bf16x8 ak[4], aq[4];
#pragma unroll
            for (int ks = 0; ks < 4; ++ks) { ak[ks] = *(const LAS bf16x8*)(Kb + (ct * 16 + l15) * 136 + ks * 32 + q4 * 8); aq[ks] = *(const LAS bf16x8*)(Qb + (ct * 16 + l15) * 136 + ks * 32 + q4 * 8); }
            float gcr[4], btr[4];
#pragma unroll
            for (int r = 0; r < 4; ++r) { gcr[r] = gcs[ct * 16 + q4 * 4 + r]; btr[r] = betas[ct * 16 + q4 * 4 + r]; }
#pragma unroll
            for (int mt = 0; mt < 4; ++mt) {
                f32x4 kk = (f32x4){0.f, 0.f, 0.f, 0.f}, qk = (f32x4){0.f, 0.f, 0.f, 0.f};
                if (mt <= ct) {
#pragma unroll
                    for (int ks = 0; ks < 4; ++ks) { const bf16x8 bk = *(const LAS bf16x8*)(Kb + (mt * 16 + l15) * 136 + ks * 32 + q4 * 8);
                        kk = __builtin_amdgcn_mfma_f32_16x16x32_bf16(ak[ks], bk, kk, 0, 0, 0); qk = __builtin_amdgcn_mfma_f32_16x16x32_bf16(aq[ks], bk, qk, 0, 0, 0); }
                }
                const int mcol = mt * 16 + l15; const float gcm = gcs[mcol];
#pragma unroll
                for (int r = 0; r < 4; ++r) {
                    const int c = ct * 16 + q4 * 4 + r; const float dec = __expf(fminf(gcr[r] - gcm, 0.f));
                    Mf[c * 68 + mcol] = (mcol < c) ? btr[r] * kk[r] * dec : 0.f;
                    AQK[(size_t)ch * 4096 + c * 64 + mcol] = tobf((mcol <= c) ? qk[r] * dec : 0.f);
                }
            }
        }
        __syncthreads();
        {
            const int j = wv * 64 + lane;
            float x[64];
            if (j < 128) {
#pragma unroll
                for (int c = 0; c < 64; ++c) { x[c] = bf1(Vb[c * 136 + j]) * betas[c]; if ((c & 7) == 7) asm volatile("" ::: "memory"); }
            } else {
#pragma unroll
                for (int c = 0; c < 64; ++c) { x[c] = bf1(Kb[c * 136 + j - 128]) * betas[c] * __expf(gcs[c]); if ((c & 7) == 7) asm volatile("" ::: "memory"); }
            }
#pragma unroll
            for (int c = 1; c < 64; ++c) {
                float s = x[c];
#pragma unroll
                for (int m4 = 0; m4 < (c + 3) / 4; ++m4) {
                    const f32x4 mm = *(const LAS f32x4*)(Mf + c * 68 + 4 * m4);
#pragma unroll
                    for (int k = 0; k < 4; ++k) if (4 * m4 + k < c) s -= mm[k] * x[4 * m4 + k];
                }
                x[c] = s;
                asm volatile("" ::: "memory");
            }
            bf16_t* dst = QKV + (size_t)row0 * 3072 + (j < 128 ? 2048 + h * 128 + j : 1024 + h * 128 + (j - 128));
#pragma unroll
            for (int c = 0; c < 64; ++c) { *dst = tobf(x[c]); dst += 3072; asm volatile("" : "+v"(dst)); }
        }
        {
            const int d = t >> 1, c0 = (t & 1) * 32; const float gl = gcs[63];
#pragma unroll
            for (int c8 = 0; c8 < 4; ++c8) {
                float v[8];
#pragma unroll
                for (int i = 0; i < 8; ++i) { const int c = c0 + c8 * 8 + i; v[i] = bf1(Kb[c * 136 + d]) * __expf(gl - gcs[c]); }
                u32x4 pk; pk.x = pk2(v[0], v[1]); pk.y = pk2(v[2], v[3]); pk.z = pk2(v[4], v[5]); pk.w = pk2(v[6], v[7]);
                *(u32x4*)(KT + (size_t)ch * 8192 + d * 64 + c0 + c8 * 8) = pk;
            }
            if (t < 64) EGC[(size_t)ch * 64 + t] = __expf(gcs[t]);
        }
        __syncthreads();
    }
}

__device__ __forceinline__ void phase_gdn_scan(const Args& a, LAS unsigned char* lds, int G, int tid) {
    const bf16_t* QKV = (const bf16_t*)(a.ws + WS_QKV); const bf16_t* KT = (const bf16_t*)(a.ws + WS_KT); const bf16_t* AQK = (const bf16_t*)(a.ws + WS_AQK); const float* EGC = (const float*)(a.ws + WS_EGC);
    bf16_t* O = (bf16_t*)a.out;
    LAS bf16_t* ST = (LAS bf16_t*)lds;
    LAS bf16_t* VT = (LAS bf16_t*)(lds + 32 * 136 * 2);
    const int w = tid >> 6, lane = tid & 63, l15 = lane & 15, q4 = lane >> 4, ct = w >> 1, et = w & 1;
    for (int it = blockIdx.x; it < 256; it += G) {
        const int b = it >> 5, h = (it >> 2) & 7, e0 = (it & 3) * 32;
        f32x4 Sacc[2] = {(f32x4){0.f, 0.f, 0.f, 0.f}, (f32x4){0.f, 0.f, 0.f, 0.f}};
        for (int i = tid; i < 32 * 136 / 2; i += NTHR) ((LAS unsigned*)ST)[i] = 0u;
        __syncthreads();
        for (int n = 0; n < 32; ++n) {
            const int ch = (b * 8 + h) * 32 + n, row0 = b * SEQ + n * 64;
            const bf16_t* rowp = QKV + (size_t)(row0 + ct * 16 + l15) * 3072 + h * 128 + q4 * 8;
            bf16x8 qA[4], wA[4], aA[2], kA[2];
#pragma unroll
            for (int ks = 0; ks < 4; ++ks) { qA[ks] = *(const bf16x8*)(rowp + ks * 32); wA[ks] = *(const bf16x8*)(rowp + 1024 + ks * 32); }
#pragma unroll
            for (int ks = 0; ks < 2; ++ks) { aA[ks] = *(const bf16x8*)(AQK + (size_t)ch * 4096 + (ct * 16 + l15) * 64 + ks * 32 + q4 * 8); kA[ks] = *(const bf16x8*)(KT + (size_t)ch * 8192 + (w * 16 + l15) * 64 + ks * 32 + q4 * 8); }
            float uu[4], eg[4];
#pragma unroll
            for (int r = 0; r < 4; ++r) { const int c = ct * 16 + q4 * 4 + r; uu[r] = bf1(QKV[(size_t)(row0 + c) * 3072 + 2048 + h * 128 + e0 + et * 16 + l15]); eg[r] = EGC[(size_t)ch * 64 + c]; }
            const float egl = EGC[(size_t)ch * 64 + 63];
            f32x4 wsv = (f32x4){0.f, 0.f, 0.f, 0.f}, qsv = (f32x4){0.f, 0.f, 0.f, 0.f};
#pragma unroll
            for (int ks = 0; ks < 4; ++ks) { const bf16x8 sB = *(const LAS bf16x8*)(ST + (et * 16 + l15) * 136 + ks * 32 + q4 * 8);
                wsv = __builtin_amdgcn_mfma_f32_16x16x32_bf16(wA[ks], sB, wsv, 0, 0, 0); qsv = __builtin_amdgcn_mfma_f32_16x16x32_bf16(qA[ks], sB, qsv, 0, 0, 0); }
            { u32x2 pk; pk.x = pk2(uu[0] - wsv[0], uu[1] - wsv[1]); pk.y = pk2(uu[2] - wsv[2], uu[3] - wsv[3]);
              *(LAS u32x2*)(VT + (et * 16 + l15) * 72 + ct * 16 + q4 * 4) = pk; }
            __syncthreads();
            f32x4 av = (f32x4){0.f, 0.f, 0.f, 0.f};
#pragma unroll
            for (int ks = 0; ks < 2; ++ks) { const bf16x8 vB = *(const LAS bf16x8*)(VT + (et * 16 + l15) * 72 + ks * 32 + q4 * 8); av = __builtin_amdgcn_mfma_f32_16x16x32_bf16(aA[ks], vB, av, 0, 0, 0); }
#pragma unroll
            for (int r = 0; r < 4; ++r) { const int c = ct * 16 + q4 * 4 + r; O[(size_t)(row0 + c) * DM + h * 128 + e0 + et * 16 + l15] = tobf(qsv[r] * eg[r] + av[r]); }
#pragma unroll
            for (int e2 = 0; e2 < 2; ++e2) {
                f32x4 up = (f32x4){0.f, 0.f, 0.f, 0.f};
#pragma unroll
                for (int ks = 0; ks < 2; ++ks) { const bf16x8 vB = *(const LAS bf16x8*)(VT + (e2 * 16 + l15) * 72 + ks * 32 + q4 * 8); up = __builtin_amdgcn_mfma_f32_16x16x32_bf16(kA[ks], vB, up, 0, 0, 0); }
                Sacc[e2] = Sacc[e2] * egl + up;
                u32x2 pk; pk.x = pk2(Sacc[e2][0], Sacc[e2][1]); pk.y = pk2(Sacc[e2][2], Sacc[e2][3]);
                *(LAS u32x2*)(ST + (e2 * 16 + l15) * 136 + w * 16 + q4 * 4) = pk;
            }
            __syncthreads();
        }
    }
}

#define XB_TMO      128
#define XB_XCNT(j)  (256  + 64 * (j))
#define XB_XSUB(j)  (1280 + 64 * (j))
#define XB_XGEN(j)  (2304 + 64 * (j))
#define XB_TOP      3328
#define XB_TOPGEN   3392
#define XCD_BAR_WORDS 3456
#define XB_SPIN_CAP (1u << 18)

__device__ __forceinline__ unsigned xb_ld(unsigned* p)              { return __hip_atomic_load(p, __ATOMIC_RELAXED, __HIP_MEMORY_SCOPE_AGENT); }
__device__ __forceinline__ unsigned xb_add(unsigned* p, unsigned v) { return __hip_atomic_fetch_add(p, v, __ATOMIC_RELAXED, __HIP_MEMORY_SCOPE_AGENT); }
__device__ __forceinline__ unsigned xb_xcc_id() { return (unsigned)__builtin_amdgcn_s_getreg((3 << 11) | 20) & 0xFu; }
#define XB_SPIN(cond, bar) do { unsigned _sp = 0; while (cond) { __builtin_amdgcn_s_sleep(1); \
    if ((++_sp & 255u) == 0u) { if (xb_ld(&(bar)[XB_TMO])) break; if (_sp > XB_SPIN_CAP) { atomicAdd(&(bar)[XB_TMO], 1u); break; } } } } while (0)

struct XcdBarrier {
    unsigned* bar; unsigned x;
    volatile __attribute__((address_space(3))) unsigned* st;
};

__device__ __forceinline__ XcdBarrier xcd_barrier_post(unsigned* bar, volatile __attribute__((address_space(3))) unsigned* st) {
    XcdBarrier b; b.bar = bar; b.x = xb_xcc_id(); b.st = st;
    if (threadIdx.x == 0) (void)xb_add(&bar[XB_XCNT(b.x)], 1u);
    return b;
}
__device__ __forceinline__ void xcd_barrier_complete(unsigned* bar, unsigned x, unsigned& nloc, unsigned& nx) {
    const unsigned G = gridDim.x * gridDim.y * gridDim.z;
    unsigned sum, cnt, mine, sp = 0u;
    for (;;) {
        sum = 0u; cnt = 0u; mine = 0u;
#pragma unroll
        for (unsigned j = 0; j < 16; ++j) { const unsigned c = xb_ld(&bar[XB_XCNT(j)]); sum += c; cnt += (c > 0u) ? 1u : 0u; mine = (j == x) ? c : mine; }
        if (sum == G) break;
        __builtin_amdgcn_s_sleep(1);
        if ((++sp & 255u) == 0u) { if (xb_ld(&bar[XB_TMO])) break; if (sp > XB_SPIN_CAP) { atomicAdd(&bar[XB_TMO], 1u); break; } }
    }
    nloc = mine > 0u ? mine : 1u; nx = cnt > 0u ? cnt : 1u;
}

__device__ __forceinline__ void xcd_barrier(const XcdBarrier& b) {
    asm volatile("s_waitcnt vmcnt(0)" ::: "memory");
    __syncthreads();
    if (threadIdx.x == 0) {
        unsigned* bar = b.bar;
        __builtin_amdgcn_s_waitcnt(0);
        unsigned nloc = b.st[0], nx = b.st[1];
        if (nloc == 0u) { xcd_barrier_complete(bar, b.x, nloc, nx); b.st[0] = nloc; b.st[1] = nx; }
        const unsigned old = xb_add(&bar[XB_XSUB(b.x)], 1u);
        const unsigned gen = old / nloc;
        if (old + 1u == (gen + 1u) * nloc) {
            __builtin_amdgcn_fence(__ATOMIC_RELEASE, "agent");
            asm volatile("s_waitcnt vmcnt(0)" ::: "memory");
            const unsigned og = xb_add(&bar[XB_TOP], 1u);
            const unsigned tg = og / nx;
            if (og + 1u == (tg + 1u) * nx) xb_add(&bar[XB_TOPGEN], 1u);
            else XB_SPIN(xb_ld(&bar[XB_TOPGEN]) == tg, bar);
            __builtin_amdgcn_fence(__ATOMIC_ACQUIRE, "agent");
            xb_add(&bar[XB_XGEN(b.x)], 1u);
            asm volatile("s_waitcnt vmcnt(0)" ::: "memory");
        } else {
            XB_SPIN(xb_ld(&bar[XB_XGEN(b.x)]) == gen, bar);
            __builtin_amdgcn_fence(__ATOMIC_ACQUIRE, "agent");
            asm volatile("s_waitcnt vmcnt(0)" ::: "memory");
        }
    }
    __syncthreads();
}

__device__ __forceinline__ void grid_bar(unsigned* cnt, unsigned target) {
    asm volatile("s_waitcnt vmcnt(0) lgkmcnt(0)" ::: "memory");
    __syncthreads();
    if (threadIdx.x == 0) {
        __builtin_amdgcn_fence(__ATOMIC_RELEASE, "agent");
        asm volatile("s_waitcnt vmcnt(0)" ::: "memory");
        __hip_atomic_fetch_add(cnt, 1u, __ATOMIC_RELAXED, __HIP_MEMORY_SCOPE_AGENT);
        unsigned spins = 0;
        while (__hip_atomic_load(cnt, __ATOMIC_RELAXED, __HIP_MEMORY_SCOPE_AGENT) < target) { __builtin_amdgcn_s_sleep(1); if (++spins > (1u << 24)) break; }
    }
    __syncthreads();
    asm volatile("buffer_inv sc1\n\ts_waitcnt vmcnt(0)" ::: "memory");
    __syncthreads();
}
struct AttnQKOrder {
    int G, c;
    __device__ __forceinline__ bool next(int i, pg8::Unit& u) const { const int L = i * G + c; if (L >= 256) return false; const int b = L >> 5, h = (L >> 3) & 3, qt = L & 7;
        u.pm = b * 8 + qt; u.pn = b; u.aoff = (unsigned)h * 512u; u.boff = (unsigned)h * 512u; u.tag = L; return true; }
};
struct AttnPVOrder {
    int G, c;
    __device__ __forceinline__ bool next(int i, pg8::Unit& u) const { const int L = i * G + c; if (L >= 256) return false; u.pm = L; u.pn = L >> 3; u.aoff = 0; u.boff = 0; u.tag = L; return true; }
    __device__ __forceinline__ void a_ready(const pg8::Unit&) const {}
    __device__ __forceinline__ void done(const pg8::Unit&) const {}
};

#ifndef PH_LAST
#define PH_LAST 19
#endif
#ifndef PH_MASK
#define PH_MASK 0xFFFFFu
#endif

__global__ void __launch_bounds__(NTHR, 2) fwd_kernel(Args a) {
    extern __shared__ __attribute__((aligned(16))) unsigned char lds_raw[];
    cg::grid_group grid = cg::this_grid();
    LAS unsigned char* lds = (LAS unsigned char*)lds_raw;
    const int G = gridDim.x, bx = blockIdx.x, NGW = G * NWAVES;
#define IDS int tid = threadIdx.x; asm volatile("" : "+v"(tid)); const int lane = tid & 63, wave = __builtin_amdgcn_readfirstlane(tid >> 6), gw = bx * NWAVES + wave; (void)lane; (void)gw;
    unsigned char* ws = a.ws;
    bf16_t* XB = (bf16_t*)(ws + WS_XB);
    float* XF = a.out;
    const int lo = a.ph_lo, hi = a.ph_hi;
    { volatile LAS unsigned* stw = (volatile LAS unsigned*)(lds + LDS_BYTES - 64); if (threadIdx.x < 4) stw[threadIdx.x] = 0u; }
    __syncthreads();
    XcdBarrier xbar = xcd_barrier_post((unsigned*)(ws + WS_CTL), (volatile LAS unsigned*)(lds + LDS_BYTES - 64));
    if (lo > 1000) grid.sync();
#define IN(k) (lo <= (k) && (k) <= hi && (k) <= PH_LAST && ((PH_MASK >> (k)) & 1u))
#define SEAM(k) do { if (IN(k) && IN((k) + 1)) { xcd_barrier(xbar); } } while (0)
    using namespace pg8;

    if (IN(0)) { IDS phase_prologue(a, lds, gw, NGW, wave, lane); }
    SEAM(0);
    if (IN(1)) {
        { Gemm g{XB, (const bf16_t*)(ws + W_GU1), DM, DM, DM}; StaticOrder S; S.init(M, 2 * DFF, G, bx); EpiPair<0> E{(bf16_t*)(ws + WS_H), DFF, 0};
          gemm_phase<EpiPair<0>, StaticOrder, true, true>(lds, g, S, E); }
        __syncthreads();
        { Gemm g{(const bf16_t*)(ws + WS_MEMB), (const bf16_t*)(ws + W_XKV), DM, DM, DM}; KVOrder S{G, bx}; EpiKV E{(bf16_t*)(ws + WS_K), (bf16_t*)(ws + WS_VT)};
          gemm_phase<EpiKV, KVOrder, true, true>(lds, g, S, E); }
    }
    SEAM(1);
    if (IN(2)) {
        Gemm g{(const bf16_t*)(ws + WS_H), (const bf16_t*)(ws + W_D1), DFF, DFF, DFF}; StaticOrder S; S.init(M, DM, G, bx); EpiResid<false> E{a.in[0], XF, ALPHA, 0.5f};
        gemm_phase<EpiResid<false>, StaticOrder, true, true>(lds, g, S, E);
    }
    SEAM(2);
    if (IN(3)) { IDS phase_ln(XF, nullptr, XB, a.in[5], a.in[6], gw, NGW, lane); }
    SEAM(3);
    if (IN(4)) {
        Gemm g{XB, (const bf16_t*)(ws + W_INA), DM, DM, DM}; StaticOrder S; S.init(M, 3328, G, bx); EpiQKV E{(bf16_t*)(ws + WS_QKV), (bf16_t*)(ws + WS_HALO), (float*)(ws + WS_AB)};
        gemm_phase<EpiQKV, StaticOrder, true, true>(lds, g, S, E);
    }
    SEAM(4);
    if (IN(5)) { IDS phase_gdn_prep(a, lds, G, tid); }
    SEAM(5);
    if (IN(6)) { IDS phase_gdn_scan(a, lds, G, tid); }
    SEAM(6);
    if (IN(7)) {
        { Gemm g{XB, (const bf16_t*)(ws + W_INB), DM, DM, DM}; StaticOrder S; S.init(M, 3072, G, bx); EpiZGG E{(bf16_t*)((unsigned char*)a.out + 32 * MiB), (bf16_t*)(ws + WS_C), (bf16_t*)(ws + WS_G)};
          gemm_phase<EpiZGG, StaticOrder, true, true>(lds, g, S, E); }
        __syncthreads();
        { Gemm g{XB, (const bf16_t*)(ws + W_INB) + (size_t)3072 * DM, DM, DM, DM}; StaticOrder S; S.init(M, 2048, G, bx); EpiAct<2> E{(bf16_t*)(ws + WS_G), 2048, 0};
          gemm_phase<EpiAct<2>, StaticOrder, true, true>(lds, g, S, E); }
    }
    SEAM(7);
    if (IN(8)) { IDS
        phase_conv31((const bf16_t*)(ws + WS_C), (bf16_t*)(ws + WS_CC), a.in[13], a.in[14], a.in[15], a.in[16], lds, G, tid);
        phase_gate_rms((bf16_t*)a.out, (const bf16_t*)((unsigned char*)a.out + 32 * MiB), a.in[11], gw, NGW, lane);
    }
    SEAM(8);
    if (IN(9)) {
        bf16_t* T = (bf16_t*)((unsigned char*)a.out + 32 * MiB);
        { Gemm g{(const bf16_t*)a.out, (const bf16_t*)(ws + W_GDN), DM, DM, DM}; StaticOrder S; S.init(M, DM, G, bx); EpiGate1 E{(const bf16_t*)(ws + WS_G), T};
          gemm_phase<EpiGate1, StaticOrder, true, true>(lds, g, S, E); }
        __syncthreads();
        { Gemm g{(const bf16_t*)(ws + WS_CC), (const bf16_t*)(ws + W_CONV), DM, DM, DM}; StaticOrder S; S.init(M, DM, G, bx); EpiGate2 E{(const bf16_t*)(ws + WS_G), T, a.in[18], (bf16_t*)(ws + WS_YMIX)};
          gemm_phase<EpiGate2, StaticOrder, true, true>(lds, g, S, E); }
    }
    SEAM(9);
    if (IN(10)) {
        Gemm g{(const bf16_t*)(ws + WS_YMIX), (const bf16_t*)(ws + W_MIX), DM, DM, DM}; StaticOrder S; S.init(M, DM, G, bx); EpiResid<true> E{XB, XF, ALPHA, 1.0f};
        gemm_phase<EpiResid<true>, StaticOrder, true, true>(lds, g, S, E);
    }
    SEAM(10);
    if (IN(11)) { IDS phase_ln(XF, XF, XB, a.in[20], a.in[21], gw, NGW, lane); }
    SEAM(11);
    if (IN(12)) {
        Gemm g{XB, (const bf16_t*)(ws + W_XQ), DM, DM, DM}; StaticOrder S; S.init(M, DM, G, bx); EpiAct<0> E{(bf16_t*)(ws + WS_Q), DM, 0};
        gemm_phase<EpiAct<0>, StaticOrder, true, true>(lds, g, S, E);
    }
    SEAM(12);
    if (IN(13)) {
        int k256 = 256; asm volatile("" : "+s"(k256));
        Gemm g{(const bf16_t*)(ws + WS_Q), (const bf16_t*)(ws + WS_K), k256, DM, DM}; AttnQKOrder S{G, bx}; EpiSoftmax E{(bf16_t*)(ws + WS_P), 0.0625f};
        Unit u;
        for (int i = 0; S.next(i, u); ++i) { SingleUnit s1{u}; gemm_phase<EpiSoftmax, SingleUnit, false, true>(lds, g, s1, E); __syncthreads(); }
    }
    SEAM(13);
    if (IN(14)) {
        int k256 = 256; asm volatile("" : "+s"(k256));
        Gemm g{(const bf16_t*)(ws + WS_P), (const bf16_t*)(ws + WS_VT), k256, 256, 256}; AttnPVOrder S{G, bx}; EpiPlainNP E{(bf16_t*)(ws + WS_O), DM, 1};
        gemm_phase<EpiPlainNP, AttnPVOrder, true, true>(lds, g, S, E);
    }
    SEAM(14);
    if (IN(15)) {
        Gemm g{(const bf16_t*)(ws + WS_O), (const bf16_t*)(ws + W_XO), DM, DM, DM}; StaticOrder S; S.init(M, DM, G, bx); EpiResid<false> E{XF, XF, ALPHA, 1.0f};
        gemm_phase<EpiResid<false>, StaticOrder, true, true>(lds, g, S, E);
    }
    SEAM(15);
    if (IN(16)) { IDS phase_ln(XF, XF, XB, a.in[25], a.in[26], gw, NGW, lane); }
    SEAM(16);
    if (IN(17)) {
        Gemm g{XB, (const bf16_t*)(ws + W_GU2), DM, DM, DM}; StaticOrder S; S.init(M, 2 * DFF, G, bx); EpiPair<0> E{(bf16_t*)(ws + WS_H), DFF, 0};
        gemm_phase<EpiPair<0>, StaticOrder, true, true>(lds, g, S, E);
    }
    SEAM(17);
    if (IN(18)) {
        Gemm g{(const bf16_t*)(ws + WS_H), (const bf16_t*)(ws + W_D2), DFF, DFF, DFF}; StaticOrder S; S.init(M, DM, G, bx); EpiResid<false> E{XF, XF, ALPHA, 0.5f};
        gemm_phase<EpiResid<false>, StaticOrder, true, true>(lds, g, S, E);
    }
    SEAM(18);
    if (IN(19)) { IDS phase_ln(XF, XF, nullptr, a.in[30], a.in[31], gw, NGW, lane); }
#undef IN
#undef SEAM
}

extern "C" void kernel_launch(void* const* d_in, const int* in_sizes, int n_in, void* d_out, int out_size, void* d_ws, size_t ws_size, hipStream_t stream) {
    static int grid_blocks = 0;
    if (!grid_blocks) {
        int dev = 0, cus = 0, per_cu = 0;
        hipGetDevice(&dev);
        hipDeviceGetAttribute(&cus, hipDeviceAttributeMultiprocessorCount, dev);
        hipFuncSetAttribute((const void*)fwd_kernel, hipFuncAttributeMaxDynamicSharedMemorySize, LDS_BYTES);
        hipOccupancyMaxActiveBlocksPerMultiprocessor(&per_cu, (const void*)fwd_kernel, NTHR, LDS_BYTES);
        if (per_cu < 1) { fprintf(stderr, "occupancy query says %d blocks/CU\n", per_cu); per_cu = 1; }
        grid_blocks = cus * per_cu;
        if (grid_blocks > 256) grid_blocks = 256;
    }
    (void)hipMemsetAsync((char*)d_ws + WS_CTL, 0, 16384, stream);
    Args a{};
    for (int i = 0; i < 32; ++i) a.in[i] = (const float*)d_in[i];
    a.out = (float*)d_out; a.ws = (unsigned char*)d_ws; a.ph_lo = 0; a.ph_hi = 99;
    void* args[] = {&a};
    hipError_t e = hipLaunchCooperativeKernel((const void*)fwd_kernel, dim3(grid_blocks), dim3(NTHR), args, LDS_BYTES, stream);
    if (e != hipSuccess) fprintf(stderr, "cooperative launch failed: %s (grid %d)\n", hipGetErrorString(e), grid_blocks);
}
```

```cpp
#include <hip/hip_runtime.h>
#include <hip/hip_cooperative_groups.h>
#include <cstdint>
#include <cstdio>
namespace cg = cooperative_groups;

namespace pg8 {
#define PG8_LAS __attribute__((address_space(3)))
typedef unsigned short bf16_t;
typedef short bf16x8 __attribute__((ext_vector_type(8)));
typedef float f32x4 __attribute__((ext_vector_type(4)));
typedef float f32x2 __attribute__((ext_vector_type(2)));
typedef unsigned u32x4 __attribute__((ext_vector_type(4)));
typedef unsigned u32x2 __attribute__((ext_vector_type(2)));
constexpr int BM = 256, BK = 64, HALF = 128, HTB = HALF * BK * 2, STAGE_BYTES = 8 * HTB, NXCD = 8, WGM = 8;

__host__ __device__ __forceinline__ int lds_byte(int r, int c) { const int st = (r >> 4) * 2 + (c >> 5), rr = r & 15, cc = c & 31, ob = rr * 64 + cc * 2; return st * 1024 + (ob ^ (((ob >> 9) & 1) << 5)); }
__host__ __device__ __forceinline__ void stage_rc(int b, int& R, int& C) { const int st = b / 1024, sb = b % 1024, swz = sb ^ (((sb >> 9) & 1) << 5); R = (st >> 1) * 16 + swz / 64; C = (st & 1) * 32 + (swz % 64) / 2; }
__host__ __device__ __forceinline__ int perm32(int rho) { const int n = rho >> 4, i = rho & 15; return 8 * (i >> 2) + 4 * n + (i & 3); }

struct Unit { int pm, pn; unsigned aoff, boff; int tag; };
struct Gemm { const bf16_t* A; const bf16_t* Bt; int K, lda, ldb; };

struct StaticOrder {
    int nM, nN, nwg, G, c;
    __device__ __forceinline__ void init(int M, int N, int G_, int c_) { nM = M / BM; nN = N / BM; nwg = nM * nN; G = G_; c = c_; }
    __device__ __forceinline__ bool next(int i, Unit& u) const {
        const long L = (long)i * G + c; if (L >= nwg) return false;
        int wgid = (int)L; { const int q = nwg / NXCD, r = nwg % NXCD, xcd = wgid % NXCD, off = wgid / NXCD; wgid = (xcd < r ? xcd * (q + 1) : r * (q + 1) + (xcd - r) * q) + off; }
        const int nig = WGM * nN, gid = wgid / nig, fm = gid * WGM, gsz = (nM - fm) < WGM ? (nM - fm) : WGM;
        u.pm = fm + ((wgid % nig) % gsz); u.pn = (wgid % nig) / gsz; u.aoff = 0; u.boff = 0; u.tag = 0; return true;
    }
    __device__ __forceinline__ void a_ready(const Unit&) const {}
    __device__ __forceinline__ void done(const Unit&) const {}
};
struct SingleUnit {
    Unit u0;
    __device__ __forceinline__ bool next(int i, Unit& u) const { if (i != 0) return false; u = u0; return true; }
    __device__ __forceinline__ void a_ready(const Unit&) const {}
    __device__ __forceinline__ void done(const Unit&) const {}
};
struct KVOrder {
    int G, c;
    __device__ __forceinline__ bool next(int i, Unit& u) const { const int cc = (c + G - (128 % G)) % G; const int L = i * G + cc; if (L >= 64) return false; u.pm = L >> 3; u.pn = L & 7; u.aoff = 0; u.boff = 0; u.tag = L; return true; }
    __device__ __forceinline__ void a_ready(const Unit&) const {}
    __device__ __forceinline__ void done(const Unit&) const {}
};

typedef __bf16 bf16x2_hw __attribute__((ext_vector_type(2)));
__device__ __forceinline__ unsigned cvt_pk_bf16(float lo, float hi) { f32x2 v = {lo, hi}; bf16x2_hw b = __builtin_convertvector(v, bf16x2_hw); return __builtin_bit_cast(unsigned, b); }
__device__ __forceinline__ float bf_lo(unsigned w) { return __uint_as_float(w << 16); }
__device__ __forceinline__ float bf_hi(unsigned w) { return __uint_as_float(w & 0xffff0000u); }
__device__ __forceinline__ float sigm(float x) { return __builtin_amdgcn_rcpf(1.f + __expf(-x)); }
__device__ __forceinline__ float silu(float x) { return x * sigm(x); }
__device__ __forceinline__ u32x4 pack8(const f32x4 a, const f32x4 b) { u32x4 w; w.x = cvt_pk_bf16(a[0], a[1]); w.y = cvt_pk_bf16(a[2], a[3]); w.z = cvt_pk_bf16(b[0], b[1]); w.w = cvt_pk_bf16(b[2], b[3]); return w; }


template <int MODE> struct EpiPair {
    static constexpr bool PERM = true, AFTER_DRAIN = false;
    bf16_t* O; int ldc; int pn0;
    __device__ __forceinline__ void operator()(const f32x4 (&acc)[2][2][4][2], const Unit& u, int wr, int wc, int fr, int fq) const {
        const int row0 = u.pm * BM + wr * 64 + fr, col0 = (u.pn - pn0) * HALF + wc * 32 + 8 * fq;
#pragma unroll
        for (int ai = 0; ai < 2; ++ai)
#pragma unroll
            for (int m = 0; m < 4; ++m) {
                f32x4 o[2];
#pragma unroll
                for (int n = 0; n < 2; ++n)
#pragma unroll
                    for (int i = 0; i < 4; ++i) { const float l = acc[ai][0][m][n][i], r = acc[ai][1][m][n][i]; o[n][i] = MODE == 0 ? silu(l) * r : l * sigm(r); }
                *(u32x4*)(O + (size_t)(row0 + ai * HALF + m * 16) * ldc + col0) = pack8(o[0], o[1]);
            }
    }
};
template <int ACT> struct EpiAct {
    static constexpr bool PERM = true, AFTER_DRAIN = false;
    bf16_t* O; int ldc; int pn0;
    __device__ __forceinline__ void operator()(const f32x4 (&acc)[2][2][4][2], const Unit& u, int wr, int wc, int fr, int fq) const {
        const int row0 = u.pm * BM + wr * 64 + fr, col0 = (u.pn - pn0) * BM + wc * 32 + 8 * fq;
#pragma unroll
        for (int ai = 0; ai < 2; ++ai)
#pragma unroll
            for (int m = 0; m < 4; ++m)
#pragma unroll
                for (int bj = 0; bj < 2; ++bj) {
                    f32x4 o[2];
#pragma unroll
                    for (int n = 0; n < 2; ++n)
#pragma unroll
                        for (int i = 0; i < 4; ++i) { const float v = acc[ai][bj][m][n][i]; o[n][i] = ACT == 1 ? silu(v) : (ACT == 2 ? sigm(v) : v); }
                    *(u32x4*)(O + (size_t)(row0 + ai * HALF + m * 16) * ldc + col0 + bj * HALF) = pack8(o[0], o[1]);
                }
    }
};
struct EpiQKV {
    static constexpr bool PERM = true, AFTER_DRAIN = false;
    bf16_t* QKV; bf16_t* HALO; float* AB;
    __device__ __forceinline__ void operator()(const f32x4 (&acc)[2][2][4][2], const Unit& u, int wr, int wc, int fr, int fq) const {
        const int row0 = u.pm * BM + wr * 64 + fr;
        if (u.pn < 12) {
            const int col0 = u.pn * BM + wc * 32 + 8 * fq;
#pragma unroll
            for (int ai = 0; ai < 2; ++ai)
#pragma unroll
                for (int m = 0; m < 4; ++m) {
                    const int row = row0 + ai * HALF + m * 16;
#pragma unroll
                    for (int bj = 0; bj < 2; ++bj) {
                        const u32x4 w = pack8(acc[ai][bj][m][0], acc[ai][bj][m][1]);
                        *(u32x4*)(QKV + (size_t)row * 3072 + col0 + bj * HALF) = w;
                        if ((row & 63) >= 61) *(u32x4*)(HALO + (size_t)((row >> 6) * 3 + (row & 63) - 61) * 3072 + col0 + bj * HALF) = w;
                    }
                }
        } else if (wc == 0 && fq < 2) {
#pragma unroll
            for (int ai = 0; ai < 2; ++ai)
#pragma unroll
                for (int m = 0; m < 4; ++m) {
                    float* p = AB + (size_t)(row0 + ai * HALF + m * 16) * 16 + 8 * fq;
                    *(f32x4*)p = acc[ai][0][m][0]; *(f32x4*)(p + 4) = acc[ai][0][m][1];
                }
        }
    }
};
struct EpiZGG {
    static constexpr bool PERM = true, AFTER_DRAIN = false;
    bf16_t* Z; bf16_t* C; bf16_t* G;
    __device__ __forceinline__ void operator()(const f32x4 (&acc)[2][2][4][2], const Unit& u, int wr, int wc, int fr, int fq) const {
        if (u.pn < 4) { EpiAct<1> e{Z, 1024, 0}; e(acc, u, wr, wc, fr, fq); }
        else if (u.pn < 12) { EpiPair<1> e{C, 1024, 4}; e(acc, u, wr, wc, fr, fq); }
        else { EpiAct<2> e{G, 2048, 12}; e(acc, u, wr, wc, fr, fq); }
    }
};
struct EpiGate1 {
    static constexpr bool PERM = true, AFTER_DRAIN = false;
    const bf16_t* G; bf16_t* T;
    __device__ __forceinline__ void operator()(const f32x4 (&acc)[2][2][4][2], const Unit& u, int wr, int wc, int fr, int fq) const {
        const int row0 = u.pm * BM + wr * 64 + fr, col0 = u.pn * BM + wc * 32 + 8 * fq;
#pragma unroll
        for (int ai = 0; ai < 2; ++ai)
#pragma unroll
            for (int m = 0; m < 4; ++m)
#pragma unroll
                for (int bj = 0; bj < 2; ++bj) {
                    const size_t r = (size_t)(row0 + ai * HALF + m * 16); const int c = col0 + bj * HALF;
                    const u32x4 g = *(const u32x4*)(G + r * 2048 + c);
                    f32x4 a = acc[ai][bj][m][0], b = acc[ai][bj][m][1];
                    a[0] *= bf_lo(g.x); a[1] *= bf_hi(g.x); a[2] *= bf_lo(g.y); a[3] *= bf_hi(g.y); b[0] *= bf_lo(g.z); b[1] *= bf_hi(g.z); b[2] *= bf_lo(g.w); b[3] *= bf_hi(g.w);
                    *(u32x4*)(T + r * 1024 + c) = pack8(a, b);
                }
    }
};
struct EpiGate2 {
    static constexpr bool PERM = true, AFTER_DRAIN = false;
    const bf16_t* G; const bf16_t* T; const float* bias; bf16_t* Y;
    __device__ __forceinline__ void operator()(const f32x4 (&acc)[2][2][4][2], const Unit& u, int wr, int wc, int fr, int fq) const {
        const int row0 = u.pm * BM + wr * 64 + fr, col0 = u.pn * BM + wc * 32 + 8 * fq;
#pragma unroll
        for (int bj = 0; bj < 2; ++bj) {
            const int c = col0 + bj * HALF;
            const f32x4 b0 = *(const f32x4*)(bias + c), b1 = *(const f32x4*)(bias + c + 4);
#pragma unroll
            for (int ai = 0; ai < 2; ++ai)
#pragma unroll
                for (int m = 0; m < 4; ++m) {
                    const size_t r = (size_t)(row0 + ai * HALF + m * 16);
                    const u32x4 g = *(const u32x4*)(G + r * 2048 + 1024 + c), t = *(const u32x4*)(T + r * 1024 + c);
                    f32x4 a = acc[ai][bj][m][0] + b0, b = acc[ai][bj][m][1] + b1;
                    a[0] = bf_lo(t.x) + a[0] * bf_lo(g.x); a[1] = bf_hi(t.x) + a[1] * bf_hi(g.x); a[2] = bf_lo(t.y) + a[2] * bf_lo(g.y); a[3] = bf_hi(t.y) + a[3] * bf_hi(g.y);
                    b[0] = bf_lo(t.z) + b[0] * bf_lo(g.z); b[1] = bf_hi(t.z) + b[1] * bf_hi(g.z); b[2] = bf_lo(t.w) + b[2] * bf_lo(g.w); b[3] = bf_hi(t.w) + b[3] * bf_hi(g.w);
                    *(u32x4*)(Y + r * 1024 + c) = pack8(a, b);
                }
        }
    }
};
template <bool RES_BF16> struct EpiResid {
    static constexpr bool PERM = false, AFTER_DRAIN = false;
    const void* res; float* out; float alpha, s;
    __device__ __forceinline__ void operator()(const f32x4 (&acc)[2][2][4][2], const Unit& u, int wr, int wc, int fr, int fq) const {
        const int row0 = u.pm * BM + wr * 64 + fr, col0 = u.pn * BM + wc * 32 + 4 * fq;
#pragma unroll
        for (int ai = 0; ai < 2; ++ai)
#pragma unroll
            for (int m = 0; m < 4; ++m)
#pragma unroll
                for (int bj = 0; bj < 2; ++bj)
#pragma unroll
                    for (int n = 0; n < 2; ++n) {
                        const size_t off = (size_t)(row0 + ai * HALF + m * 16) * 1024 + col0 + bj * HALF + n * 16;
                        f32x4 r;
                        if (RES_BF16) { const u32x2 w = *(const u32x2*)((const bf16_t*)res + off); r = (f32x4){bf_lo(w.x), bf_hi(w.x), bf_lo(w.y), bf_hi(w.y)}; }
                        else r = *(const f32x4*)((const float*)res + off);
                        *(f32x4*)(out + off) = r * alpha + acc[ai][bj][m][n] * s;
                    }
    }
};
struct EpiPlainNP {
    static constexpr bool PERM = false, AFTER_DRAIN = false;
    bf16_t* O; int ldc; int mode;
    __device__ __forceinline__ void operator()(const f32x4 (&acc)[2][2][4][2], const Unit& u, int wr, int wc, int fr, int fq) const {
        int rb = u.pm * BM, cb = u.pn * BM;
        if (mode == 1) { const int L = u.tag; rb = (L >> 5) * 2048 + (L & 7) * 256; cb = ((L >> 3) & 3) * 256; }
        const int row0 = rb + wr * 64 + fr, col0 = cb + wc * 32 + 4 * fq;
#pragma unroll
        for (int ai = 0; ai < 2; ++ai)
#pragma unroll
            for (int m = 0; m < 4; ++m)
#pragma unroll
                for (int bj = 0; bj < 2; ++bj)
#pragma unroll
                    for (int n = 0; n < 2; ++n) {
                        const f32x4 v = acc[ai][bj][m][n]; u32x2 w; w.x = cvt_pk_bf16(v[0], v[1]); w.y = cvt_pk_bf16(v[2], v[3]);
                        *(u32x2*)(O + (size_t)(row0 + ai * HALF + m * 16) * ldc + col0 + bj * HALF + n * 16) = w;
                    }
    }
};
struct EpiKV {
    static constexpr bool PERM = false, AFTER_DRAIN = false;
    bf16_t* Kb; bf16_t* VT;
    __device__ __forceinline__ void operator()(const f32x4 (&acc)[2][2][4][2], const Unit& u, int wr, int wc, int fr, int fq) const {
        if (u.pn < 4) { EpiPlainNP e{Kb, 1024, 0}; e(acc, u, wr, wc, fr, fq); return; }
        const int h = u.pn - 4, b = u.pm; bf16_t* base = VT + (size_t)(b * 4 + h) * 65536;
#pragma unroll
        for (int ai = 0; ai < 2; ++ai)
#pragma unroll
            for (int m = 0; m < 4; ++m) {
                const int mem = ai * HALF + wr * 64 + m * 16 + fr;
#pragma unroll
                for (int bj = 0; bj < 2; ++bj)
#pragma unroll
                    for (int n = 0; n < 2; ++n) {
                        const f32x4 v = acc[ai][bj][m][n]; const int hd = bj * HALF + wc * 32 + n * 16 + 4 * fq;
                        const unsigned w0 = cvt_pk_bf16(v[0], v[1]), w1 = cvt_pk_bf16(v[2], v[3]);
                        base[(size_t)(hd + 0) * 256 + mem] = (bf16_t)(w0 & 0xffffu); base[(size_t)(hd + 1) * 256 + mem] = (bf16_t)(w0 >> 16);
                        base[(size_t)(hd + 2) * 256 + mem] = (bf16_t)(w1 & 0xffffu); base[(size_t)(hd + 3) * 256 + mem] = (bf16_t)(w1 >> 16);
                    }
            }
    }
};
struct EpiSoftmax {
    static constexpr bool PERM = false, AFTER_DRAIN = true;
    bf16_t* P; float scale;
    __device__ __forceinline__ void fused(f32x4 (&acc)[2][2][4][2], const Unit& u, int wr, int wc, int fr, int fq, PG8_LAS unsigned char* lds, int wid, int lane) const {
        PG8_LAS float* PM = (PG8_LAS float*)lds;
        PG8_LAS float* PS = (PG8_LAS float*)(lds + 4096);
        const float sc = scale * 1.4426950408889634f;
#pragma unroll
        for (int ai = 0; ai < 2; ++ai)
#pragma unroll
            for (int m = 0; m < 4; ++m) {
                float mx = -3.0e38f;
#pragma unroll
                for (int bj = 0; bj < 2; ++bj)
#pragma unroll
                    for (int n = 0; n < 2; ++n) { f32x4 v = acc[ai][bj][m][n] * sc; acc[ai][bj][m][n] = v; mx = fmaxf(mx, fmaxf(fmaxf(v[0], v[1]), fmaxf(v[2], v[3]))); }
                mx = fmaxf(mx, __shfl_xor(mx, 16)); mx = fmaxf(mx, __shfl_xor(mx, 32));
                if (fq == 0) PM[(ai * HALF + wr * 64 + m * 16 + fr) * 4 + wc] = mx;
            }
        asm volatile("s_waitcnt lgkmcnt(0)" ::: "memory"); __builtin_amdgcn_s_barrier(); asm volatile("" ::: "memory");
#pragma unroll
        for (int ai = 0; ai < 2; ++ai)
#pragma unroll
            for (int m = 0; m < 4; ++m) {
                const int r = ai * HALF + wr * 64 + m * 16 + fr;
                const f32x4 pm = *(const PG8_LAS f32x4*)(PM + r * 4);
                const float mx = fmaxf(fmaxf(pm[0], pm[1]), fmaxf(pm[2], pm[3]));
                float s = 0.f;
#pragma unroll
                for (int bj = 0; bj < 2; ++bj)
#pragma unroll
                    for (int n = 0; n < 2; ++n) { f32x4 v = acc[ai][bj][m][n]; v[0] = __builtin_amdgcn_exp2f(v[0] - mx); v[1] = __builtin_amdgcn_exp2f(v[1] - mx); v[2] = __builtin_amdgcn_exp2f(v[2] - mx); v[3] = __builtin_amdgcn_exp2f(v[3] - mx);
                        acc[ai][bj][m][n] = v; s += (v[0] + v[1]) + (v[2] + v[3]); }
                s += __shfl_xor(s, 16); s += __shfl_xor(s, 32);
                if (fq == 0) PS[r * 4 + wc] = s;
            }
        asm volatile("s_waitcnt lgkmcnt(0)" ::: "memory"); __builtin_amdgcn_s_barrier(); asm volatile("" ::: "memory");
        const int L = u.tag;
#pragma unroll
        for (int ai = 0; ai < 2; ++ai)
#pragma unroll
            for (int m = 0; m < 4; ++m) {
                const int r = ai * HALF + wr * 64 + m * 16 + fr;
                const f32x4 ps = *(const PG8_LAS f32x4*)(PS + r * 4);
                const float inv = 1.0f / ((ps[0] + ps[1]) + (ps[2] + ps[3]));
#pragma unroll
                for (int bj = 0; bj < 2; ++bj)
#pragma unroll
                    for (int n = 0; n < 2; ++n) { const f32x4 v = acc[ai][bj][m][n] * inv; u32x2 w; w.x = cvt_pk_bf16(v[0], v[1]); w.y = cvt_pk_bf16(v[2], v[3]);
                        *(u32x2*)(P + ((size_t)L * 256 + r) * 256 + bj * HALF + wc * 32 + n * 16 + 4 * fq) = w; }
            }
        asm volatile("s_waitcnt lgkmcnt(0)" ::: "memory"); __builtin_amdgcn_s_barrier(); asm volatile("" ::: "memory");
    }
};

template <class Epi, class Sched, bool ALIGN_EPI = false, bool SP2 = false>
__device__ __forceinline__ void gemm_phase(PG8_LAS unsigned char* lds, const Gemm g, const Sched& S, const Epi& E) {
    const int tid = threadIdx.x, wid = __builtin_amdgcn_readfirstlane(tid >> 6), lane = tid & 63, wr = wid >> 2, wc = wid & 3, fr = lane & 15, fq = lane >> 4;
    const int K = g.K, nt = K / BK;
    unsigned voffA[2], voffB[2];
#pragma unroll
    for (int i = 0; i < 2; ++i) { int R, C; stage_rc(tid * 16 + i * 8192, R, C); const int Rb = Epi::PERM ? ((R & ~31) + perm32(R & 31)) : R;
        voffA[i] = (unsigned)(R * g.lda + C) * 2u; voffB[i] = (unsigned)(Rb * g.ldb + C) * 2u; }
    const size_t kstep = (size_t)(BK * 2);
    const size_t hstepA = (size_t)HALF * g.lda * 2, hstepB = (size_t)HALF * g.ldb * 2;
    const size_t tstepA = 2 * hstepA, tstepB = 2 * hstepB;
    const unsigned ldsw = (unsigned)wid * 1024u;
    const int aoff = lds_byte(wr * 64 + fr, fq * 8), boff = lds_byte(wc * 32 + fr, fq * 8);
#define PG8_SA(b, h) (((b) * 2 + (h)) * HTB)
#define PG8_SB(b, h) ((4 + (b) * 2 + (h)) * HTB)
#define PG8_STAGE(bufoff, gbase, voff) do { _Pragma("unroll") for (int _i = 0; _i < 2; ++_i) \
        __builtin_amdgcn_global_load_lds((const unsigned*)((const char*)(gbase) + (voff)[_i]), (PG8_LAS unsigned*)(lds + (bufoff) + ldsw + _i * 8192), 16, 0, 0); } while (0)
#define PG8_LDA(dst, b, h) do { _Pragma("unroll") for (int m = 0; m < 4; ++m) _Pragma("unroll") for (int k = 0; k < 2; ++k) dst[m][k] = *(const PG8_LAS bf16x8*)(lds + PG8_SA(b, h) + aoff + m * 2048 + k * 1024); } while (0)
#define PG8_LDB(dst, b, h) do { _Pragma("unroll") for (int n = 0; n < 2; ++n) _Pragma("unroll") for (int k = 0; k < 2; ++k) dst[n][k] = *(const PG8_LAS bf16x8*)(lds + PG8_SB(b, h) + boff + n * 2048 + k * 1024); } while (0)
#define PG8_MMA(ai, bj, At, Bt) do { __builtin_amdgcn_s_setprio(1); _Pragma("unroll") for (int m = 0; m < 4; ++m) _Pragma("unroll") for (int n = 0; n < 2; ++n) _Pragma("unroll") for (int k = 0; k < 2; ++k) \
        acc[ai][bj][m][n] = __builtin_amdgcn_mfma_f32_16x16x32_bf16(Bt[n][k], At[m][k], acc[ai][bj][m][n], 0, 0, 0); __builtin_amdgcn_s_setprio(0); } while (0)
#define PG8_WAIT_V(n) asm volatile("s_waitcnt vmcnt(" #n ")" ::: "memory")
#define PG8_WAIT_L(n) asm volatile("s_waitcnt lgkmcnt(" #n ")" ::: "memory")
#define PG8_BAR __builtin_amdgcn_s_barrier()
#define PG8_SCHED __builtin_amdgcn_sched_barrier(0)
    Unit cur, nxt; int ui = 0;
    if (!S.next(0, cur)) return;
    f32x4 acc[2][2][4][2];
#pragma unroll
    for (int a = 0; a < 2; ++a)
#pragma unroll
        for (int b = 0; b < 2; ++b)
#pragma unroll
            for (int m = 0; m < 4; ++m)
#pragma unroll
                for (int n = 0; n < 2; ++n) acc[a][b][m][n] = (f32x4){0.f, 0.f, 0.f, 0.f};
    bf16x8 At[4][2], B0[2][2], B1[2][2];
    const char* cA = (const char*)g.A + (size_t)cur.pm * tstepA + cur.aoff; const char* cB = (const char*)g.Bt + (size_t)cur.pn * tstepB + cur.boff;
    S.a_ready(cur);
    if constexpr (SP2) {
        PG8_STAGE(PG8_SB(0, 0), cB, voffB); PG8_STAGE(PG8_SB(0, 1), cB + hstepB, voffB); PG8_STAGE(PG8_SA(0, 0), cA, voffA); PG8_STAGE(PG8_SA(0, 1), cA + hstepA, voffA);
        if (wr == 1) PG8_BAR;
        PG8_WAIT_V(2); PG8_BAR;
        PG8_STAGE(PG8_SB(1, 0), cB + kstep, voffB); PG8_STAGE(PG8_SA(1, 0), cA + kstep, voffA); PG8_STAGE(PG8_SB(1, 1), cB + hstepB + kstep, voffB);
        PG8_WAIT_V(6); PG8_BAR;
    } else {
        PG8_STAGE(PG8_SB(0, 0), cB, voffB); PG8_STAGE(PG8_SA(0, 0), cA, voffA); PG8_STAGE(PG8_SB(0, 1), cB + hstepB, voffB); PG8_STAGE(PG8_SA(0, 1), cA + hstepA, voffA);
        if (wr == 1) PG8_BAR;
        PG8_WAIT_V(4); PG8_BAR;
        PG8_STAGE(PG8_SB(1, 0), cB + kstep, voffB); PG8_STAGE(PG8_SA(1, 0), cA + kstep, voffA); PG8_STAGE(PG8_SB(1, 1), cB + hstepB + kstep, voffB);
        PG8_WAIT_V(6); PG8_BAR;
    }
    for (;;) {
        const bool has_next = S.next(ui + 1, nxt);
        const char* nA = has_next ? (const char*)g.A + (size_t)nxt.pm * tstepA + nxt.aoff : cA; const char* nB = has_next ? (const char*)g.Bt + (size_t)nxt.pn * tstepB + nxt.boff : cB;
        for (int t = 0; t < nt; t += 2) {
            const bool last = (t == nt - 2);
            const char* a1 = cA + (size_t)(t + 1) * kstep;
            const char* a2 = last ? nA : cA + (size_t)(t + 2) * kstep; const char* b2 = last ? nB : cB + (size_t)(t + 2) * kstep;
            const char* a3 = a2 + kstep; const char* b3 = b2 + kstep;
            if (last && has_next) S.a_ready(nxt);
            if constexpr (SP2) {
            PG8_LDB(B0, 0, 0); PG8_LDB(B1, 0, 1); PG8_SCHED; PG8_LDA(At, 0, 0); PG8_STAGE(PG8_SA(1, 1), a1 + hstepA, voffA);
            PG8_WAIT_V(8); PG8_WAIT_L(0); PG8_BAR; PG8_MMA(0, 0, At, B0); PG8_MMA(0, 1, At, B1); PG8_BAR; PG8_SCHED;
            PG8_LDA(At, 0, 1); PG8_STAGE(PG8_SB(0, 0), b2, voffB); PG8_STAGE(PG8_SB(0, 1), b2 + hstepB, voffB); PG8_STAGE(PG8_SA(0, 0), a2, voffA);
            PG8_WAIT_V(8); PG8_WAIT_L(0); PG8_BAR; PG8_MMA(1, 0, At, B0); PG8_MMA(1, 1, At, B1); PG8_BAR; PG8_SCHED;
            PG8_LDB(B0, 1, 0); PG8_LDB(B1, 1, 1); PG8_SCHED; PG8_LDA(At, 1, 0); PG8_STAGE(PG8_SA(0, 1), a2 + hstepA, voffA);
            PG8_WAIT_V(8); PG8_WAIT_L(0); PG8_BAR; PG8_MMA(0, 0, At, B0); PG8_MMA(0, 1, At, B1); PG8_BAR; PG8_SCHED;
            PG8_LDA(At, 1, 1); PG8_STAGE(PG8_SB(1, 0), b3, voffB); PG8_STAGE(PG8_SB(1, 1), b3 + hstepB, voffB); PG8_STAGE(PG8_SA(1, 0), a3, voffA);
            PG8_WAIT_V(8); PG8_WAIT_L(0); PG8_BAR; PG8_MMA(1, 0, At, B0); PG8_MMA(1, 1, At, B1); PG8_BAR; PG8_SCHED;
            } else {
            PG8_LDB(B0, 0, 0); PG8_SCHED; PG8_LDA(At, 0, 0); PG8_STAGE(PG8_SA(1, 1), a1 + hstepA, voffA);
            PG8_WAIT_L(8); PG8_BAR; PG8_WAIT_L(0); PG8_MMA(0, 0, At, B0); PG8_BAR; PG8_SCHED;
            PG8_LDB(B1, 0, 1); PG8_STAGE(PG8_SB(0, 0), b2, voffB);
            PG8_BAR; PG8_WAIT_L(0); PG8_MMA(0, 1, At, B1); PG8_BAR;
            PG8_LDA(At, 0, 1); PG8_STAGE(PG8_SA(0, 0), a2, voffA);
            PG8_BAR; PG8_WAIT_L(0); PG8_MMA(1, 0, At, B0); PG8_BAR; PG8_SCHED;
            PG8_STAGE(PG8_SB(0, 1), b2 + hstepB, voffB);
            PG8_WAIT_V(6); PG8_BAR; PG8_MMA(1, 1, At, B1); PG8_BAR;
            PG8_LDB(B0, 1, 0); PG8_SCHED; PG8_LDA(At, 1, 0); PG8_STAGE(PG8_SA(0, 1), a2 + hstepA, voffA);
            PG8_WAIT_L(8); PG8_BAR; PG8_WAIT_L(0); PG8_MMA(0, 0, At, B0); PG8_BAR; PG8_SCHED;
            PG8_LDB(B1, 1, 1); PG8_STAGE(PG8_SB(1, 0), b3, voffB);
            PG8_BAR; PG8_WAIT_L(0); PG8_MMA(0, 1, At, B1); PG8_BAR;
            PG8_LDA(At, 1, 1); PG8_STAGE(PG8_SA(1, 0), a3, voffA);
            PG8_BAR; PG8_WAIT_L(0); PG8_MMA(1, 0, At, B0); PG8_BAR; PG8_SCHED;
            PG8_STAGE(PG8_SB(1, 1), b3 + hstepB, voffB);
            PG8_WAIT_V(6); PG8_BAR; PG8_MMA(1, 1, At, B1); PG8_BAR;
            }
        }
        if constexpr (ALIGN_EPI) { if (wr == 0) PG8_BAR; }
        if constexpr (!Epi::AFTER_DRAIN) { E(acc, cur, wr, wc, fr, fq); S.done(cur); }
        if (!has_next) break;
#pragma unroll
        for (int a = 0; a < 2; ++a)
#pragma unroll
            for (int b = 0; b < 2; ++b)
#pragma unroll
                for (int m = 0; m < 4; ++m)
#pragma unroll
                    for (int n = 0; n < 2; ++n) acc[a][b][m][n] = (f32x4){0.f, 0.f, 0.f, 0.f};
        cur = nxt; cA = nA; cB = nB; ++ui;
        if constexpr (ALIGN_EPI) { if (wr == 1) PG8_BAR; }
    }
    PG8_WAIT_V(0);
    if constexpr (!ALIGN_EPI) { if (wr == 0) PG8_BAR; }
    PG8_BAR;
    if constexpr (Epi::AFTER_DRAIN) { E.fused(acc, cur, wr, wc, fr, fq, lds, wid, lane); S.done(cur); }
#undef PG8_SA
#undef PG8_SB
#undef PG8_STAGE
#undef PG8_LDA
#undef PG8_LDB
#undef PG8_MMA
#undef PG8_WAIT_V
#undef PG8_WAIT_L
#undef PG8_BAR
#undef PG8_SCHED
}
}

using pg8::bf16_t; using pg8::f32x4; using pg8::u32x4; using pg8::u32x2; using pg8::bf16x8;
#define LAS __attribute__((address_space(3)))

constexpr int DM = 1024, NB = 8, SEQ = 2048, M = NB * SEQ, DFF = 2816, NMEM = 256, NH = 8, DK = 128, CW = 31;
constexpr float ALPHA = 1.189207115002721f, LN_EPS = 1e-5f, RMS_EPS = 1e-6f;
constexpr int NWAVES = 8, NTHR = 512;
constexpr int LDS_BYTES = 147456;

constexpr size_t MiB = 1u << 20;
constexpr size_t W_GU1 = 0, W_D1 = 11 * MiB, W_GU2 = 16 * MiB + MiB / 2, W_D2 = 27 * MiB + MiB / 2, W_INA = 33 * MiB, W_INB = 39 * MiB + MiB / 2,
                 W_GDN = 49 * MiB + MiB / 2, W_CONV = 51 * MiB + MiB / 2, W_MIX = 53 * MiB + MiB / 2, W_XQ = 55 * MiB + MiB / 2, W_XO = 57 * MiB + MiB / 2, W_XKV = 59 * MiB + MiB / 2;
constexpr size_t WS_CTL = 63 * MiB + MiB / 2 + 4096;
constexpr size_t WS_XB = 64 * MiB, WS_K = 96 * MiB, WS_VT = 100 * MiB, WS_R = 104 * MiB;
constexpr size_t WS_H = WS_R;
constexpr size_t WS_MEMB = 248 * MiB;
constexpr size_t WS_QKV = WS_R, WS_KT = 200 * MiB, WS_AQK = 232 * MiB, WS_HALO = 248 * MiB, WS_EGC = 253 * MiB, WS_AB = 254 * MiB;
constexpr size_t WS_C = WS_R, WS_G = 136 * MiB, WS_CC = 200 * MiB, WS_YMIX = WS_R;
constexpr size_t WS_Q = WS_R, WS_P = 136 * MiB, WS_O = 168 * MiB;

struct Args { const float* in[32]; float* out; unsigned char* ws; int ph_lo, ph_hi; };

struct Seg { int in, K, N, col0, ncols, row0, type; unsigned long long dst; };
__constant__ Seg c_seg[18] = {
    {2, 1024, 2816, 0, 2816, 0, 1, W_GU1}, {3, 1024, 2816, 0, 2816, 128, 1, W_GU1}, {4, 2816, 1024, 0, 1024, 0, 0, W_D1},
    {27, 1024, 2816, 0, 2816, 0, 1, W_GU2}, {28, 1024, 2816, 0, 2816, 128, 1, W_GU2}, {29, 2816, 1024, 0, 1024, 0, 0, W_D2},
    {7, 1024, 8208, 0, 3072, 0, 0, W_INA}, {7, 1024, 8208, 4096, 32, 3072, 0, W_INA},
    {7, 1024, 8208, 3072, 1024, 0, 0, W_INB}, {7, 1024, 8208, 4112, 1024, 1024, 1, W_INB}, {7, 1024, 8208, 5136, 1024, 1152, 1, W_INB}, {7, 1024, 8208, 6160, 2048, 3072, 0, W_INB},
    {12, 1024, 1024, 0, 1024, 0, 0, W_GDN}, {17, 1024, 1024, 0, 1024, 0, 0, W_CONV}, {19, 1024, 1024, 0, 1024, 0, 0, W_MIX}, {22, 1024, 1024, 0, 1024, 0, 0, W_XQ}, {24, 1024, 1024, 0, 1024, 0, 0, W_XO},
    {23, 1024, 2048, 0, 2048, 0, 0, W_XKV}};

__device__ __forceinline__ float wave_sum(float v) {
#pragma unroll
    for (int o = 1; o < 64; o <<= 1) v += __shfl_xor(v, o);
    return v;
}
__device__ __forceinline__ unsigned pk2(float lo, float hi) { return pg8::cvt_pk_bf16(lo, hi); }
__device__ __forceinline__ float bflo(unsigned w) { return __uint_as_float(w << 16); }
__device__ __forceinline__ float bfhi(unsigned w) { return __uint_as_float(w & 0xffff0000u); }
__device__ __forceinline__ float bf1(bf16_t h) { return __uint_as_float(((unsigned)h) << 16); }
__device__ __forceinline__ bf16_t tobf(float f) { return (bf16_t)(pg8::cvt_pk_bf16(f, 0.f) & 0xffffu); }

__device__ __forceinline__ void p0_item(const float* W, int K, int N, int col0, bf16_t* WT, int row0, int type, LAS float* scr, int item, int ncols, int lane) {
    const int nblk = ncols / 32, kb = item / nblk, nb = item % nblk, k0 = 64 * kb, n0 = 32 * nb;
#pragma unroll 8
    for (int i = 0; i < 32; ++i) { const int kk = 2 * i + (lane >> 5); scr[kk * 33 + (lane & 31)] = W[(size_t)(k0 + kk) * N + col0 + n0 + (lane & 31)]; }
    asm volatile("s_waitcnt lgkmcnt(0)" ::: "memory");
    const int c = lane & 7;
#pragma unroll
    for (int j = 0; j < 4; ++j) { const int n = (lane >> 3) + 8 * j; const LAS float* s = scr + (8 * c) * 33 + n;
        u32x4 o; o.x = pk2(s[0 * 33], s[1 * 33]); o.y = pk2(s[2 * 33], s[3 * 33]); o.z = pk2(s[4 * 33], s[5 * 33]); o.w = pk2(s[6 * 33], s[7 * 33]);
        const int nn = n0 + n; const int drow = type ? row0 + 256 * (nn >> 7) + (nn & 127) : row0 + nn;
        *(u32x4*)(WT + (size_t)drow * K + k0 + 8 * c) = o; }
    asm volatile("s_waitcnt lgkmcnt(0)" ::: "memory");
}
__device__ __forceinline__ void phase_prologue(const Args& a, LAS unsigned char* lds, int gw, int NGW, int wave, int lane) {
    LAS float* scr = (LAS float*)(lds + wave * 16384);
    int total = 0;
#pragma unroll 1
    for (int s = 0; s < 18; ++s) total += (c_seg[s].K / 64) * (c_seg[s].ncols / 32);
    for (int it = gw; it < total; it += NGW) {
        int r = it, s = 0;
        for (;; ++s) { const int cnt = (c_seg[s].K / 64) * (c_seg[s].ncols / 32); if (r < cnt) break; r -= cnt; }
        p0_item(a.in[c_seg[s].in], c_seg[s].K, c_seg[s].N, c_seg[s].col0, (bf16_t*)(a.ws + c_seg[s].dst), c_seg[s].row0, c_seg[s].type, scr, r, c_seg[s].ncols, lane);
    }
    { u32x4* z = (u32x4*)(a.ws + W_INA + (size_t)3104 * 1024 * 2); for (int i = gw * 64 + lane; i < 458752 / 16; i += NGW * 64) z[i] = (u32x4){0u, 0u, 0u, 0u}; }
    { const f32x4* x = (const f32x4*)a.in[0]; u32x4* o = (u32x4*)(a.ws + WS_XB);
      for (int i = gw * 64 + lane; i < M * DM / 8; i += NGW * 64) { const f32x4 v0 = x[2 * i], v1 = x[2 * i + 1]; o[i] = pg8::pack8(v0, v1); } }
    { const f32x4* x = (const f32x4*)a.in[1]; u32x4* o = (u32x4*)(a.ws + WS_MEMB);
      for (int i = gw * 64 + lane; i < NB * NMEM * DM / 8; i += NGW * 64) { const f32x4 v0 = x[2 * i], v1 = x[2 * i + 1]; o[i] = pg8::pack8(v0, v1); } }
}

__device__ __forceinline__ void phase_ln(const float* src, float* dstf, bf16_t* dstb, const float* g, const float* b, int gw, int NGW, int lane) {
    f32x4 gg[4], bb[4];
#pragma unroll
    for (int j = 0; j < 4; ++j) { gg[j] = ((const f32x4*)g)[lane + 64 * j]; bb[j] = ((const f32x4*)b)[lane + 64 * j]; }
    for (int m = gw; m < M; m += NGW) {
        const f32x4* xr = (const f32x4*)(src + (size_t)m * DM) + lane;
        f32x4 v[4]; float s = 0.f;
#pragma unroll
        for (int j = 0; j < 4; ++j) { v[j] = xr[64 * j]; s += (v[j][0] + v[j][1]) + (v[j][2] + v[j][3]); }
        const float mean = wave_sum(s) * (1.f / DM); float s2 = 0.f;
#pragma unroll
        for (int j = 0; j < 4; ++j) { v[j] = v[j] - mean; s2 += (v[j][0] * v[j][0] + v[j][1] * v[j][1]) + (v[j][2] * v[j][2] + v[j][3] * v[j][3]); }
        const float rstd = 1.f / sqrtf(wave_sum(s2) * (1.f / DM) + LN_EPS);
#pragma unroll
        for (int j = 0; j < 4; ++j) { v[j] = v[j] * rstd * gg[j] + bb[j]; }
        if (dstf) {
            f32x4* o = (f32x4*)(dstf + (size_t)m * DM) + lane;
#pragma unroll
            for (int j = 0; j < 4; ++j) o[64 * j] = v[j];
        }
        if (dstb) {
            u32x2* o = (u32x2*)(dstb + (size_t)m * DM) + lane;
#pragma unroll
            for (int j = 0; j < 4; ++j) { u32x2 w; w.x = pk2(v[j][0], v[j][1]); w.y = pk2(v[j][2], v[j][3]); o[64 * j] = w; }
        }
    }
}

__device__ __forceinline__ void phase_conv31(const bf16_t* C, bf16_t* CC, const float* w, const float* bias, const float* lg, const float* lb, LAS unsigned char* lds, int G, int tid) {
    LAS float* tile = (LAS float*)lds;
    const int wave = tid >> 6, lane = tid & 63;
    float w0[CW], w1[CW];
#pragma unroll
    for (int j = 0; j < CW; ++j) { const float2 t = *(const float2*)(w + (size_t)j * DM + 2 * tid); w0[j] = t.x; w1[j] = t.y; }
    const float2 bs = *(const float2*)(bias + 2 * tid);
    f32x4 gg[4], bb[4];
#pragma unroll
    for (int j = 0; j < 4; ++j) { gg[j] = ((const f32x4*)lg)[lane + 64 * j]; bb[j] = ((const f32x4*)lb)[lane + 64 * j]; }
    for (int it = blockIdx.x; it < M / 8; it += G) {
        const int t0 = it * 8, s0 = t0 & (SEQ - 1);
        float a0[8], a1[8];
#pragma unroll
        for (int o = 0; o < 8; ++o) { a0[o] = bs.x; a1[o] = bs.y; }
#pragma unroll
        for (int r = -(CW - 1); r < 8; ++r) {
            unsigned xw = 0u;
            if (s0 + r >= 0) xw = *(const unsigned*)(C + (size_t)(t0 + r) * DM + 2 * tid);
            const float x0 = bflo(xw), x1 = bfhi(xw);
#pragma unroll
            for (int o = 0; o < 8; ++o) { const int j = r - o + (CW - 1); if (j >= 0 && j < CW) { a0[o] += x0 * w0[j]; a1[o] += x1 * w1[j]; } }
        }
#pragma unroll
        for (int o = 0; o < 8; ++o) *(LAS pg8::f32x2*)(tile + o * DM + 2 * tid) = (pg8::f32x2){a0[o], a1[o]};
        __syncthreads();
        {
            const LAS f32x4* xr = (const LAS f32x4*)(tile + wave * DM) + lane;
            f32x4 v[4]; float s = 0.f;
#pragma unroll
            for (int j = 0; j < 4; ++j) { v[j] = xr[64 * j]; s += (v[j][0] + v[j][1]) + (v[j][2] + v[j][3]); }
            const float mean = wave_sum(s) * (1.f / DM); float s2 = 0.f;
#pragma unroll
            for (int j = 0; j < 4; ++j) { v[j] = v[j] - mean; s2 += (v[j][0] * v[j][0] + v[j][1] * v[j][1]) + (v[j][2] * v[j][2] + v[j][3] * v[j][3]); }
            const float rstd = 1.f / sqrtf(wave_sum(s2) * (1.f / DM) + LN_EPS);
            u32x2* o = (u32x2*)(CC + (size_t)(t0 + wave) * DM) + lane;
#pragma unroll
            for (int j = 0; j < 4; ++j) { f32x4 y = v[j] * rstd * gg[j] + bb[j]; u32x2 ww; ww.x = pk2(pg8::silu(y[0]), pg8::silu(y[1])); ww.y = pk2(pg8::silu(y[2]), pg8::silu(y[3])); o[64 * j] = ww; }
        }
        __syncthreads();
    }
}

__device__ __forceinline__ void phase_gate_rms(bf16_t* O, const bf16_t* Z, const float* gn, int gw, int NGW, int lane) {
    f32x4 g4[4];
#pragma unroll
    for (int j = 0; j < 4; ++j) g4[j] = ((const f32x4*)gn)[(lane & 7) * 4 + j];
    for (int m = gw; m < M; m += NGW) {
        u32x4* op = (u32x4*)(O + (size_t)m * DM) + 2 * lane; const u32x4* zp = (const u32x4*)(Z + (size_t)m * DM) + 2 * lane;
        const u32x4 o0 = op[0], o1 = op[1], z0 = zp[0], z1 = zp[1];
        float v[16] = {bflo(o0.x), bfhi(o0.x), bflo(o0.y), bfhi(o0.y), bflo(o0.z), bfhi(o0.z), bflo(o0.w), bfhi(o0.w), bflo(o1.x), bfhi(o1.x), bflo(o1.y), bfhi(o1.y), bflo(o1.z), bfhi(o1.z), bflo(o1.w), bfhi(o1.w)};
        float zz[16] = {bflo(z0.x), bfhi(z0.x), bflo(z0.y), bfhi(z0.y), bflo(z0.z), bfhi(z0.z), bflo(z0.w), bfhi(z0.w), bflo(z1.x), bfhi(z1.x), bflo(z1.y), bfhi(z1.y), bflo(z1.z), bfhi(z1.z), bflo(z1.w), bfhi(z1.w)};
        float ss = 0.f;
#pragma unroll
        for (int i = 0; i < 16; ++i) ss += v[i] * v[i];
        ss += __shfl_xor(ss, 1); ss += __shfl_xor(ss, 2); ss += __shfl_xor(ss, 4);
        const float rstd = 1.f / sqrtf(ss * (1.f / 128.f) + RMS_EPS);
#pragma unroll
        for (int i = 0; i < 16; ++i) v[i] = v[i] * rstd * g4[i >> 2][i & 3] * zz[i];
        u32x4 r0, r1; r0.x = pk2(v[0], v[1]); r0.y = pk2(v[2], v[3]); r0.z = pk2(v[4], v[5]); r0.w = pk2(v[6], v[7]); r1.x = pk2(v[8], v[9]); r1.y = pk2(v[10], v[11]); r1.z = pk2(v[12], v[13]); r1.w = pk2(v[14], v[15]);
        op[0] = r0; op[1] = r1;
    }
}

constexpr int PREP_HALF = 4 * 17408 + 1024;
static_assert(2 * PREP_HALF <= LDS_BYTES, "prep LDS");
__device__ __forceinline__ void phase_gdn_prep(const Args& a, LAS unsigned char* lds, int G, int tid) {
    bf16_t* QKV = (bf16_t*)(a.ws + WS_QKV); const bf16_t* HALO = (const bf16_t*)(a.ws + WS_HALO); const float* AB = (const float*)(a.ws + WS_AB);
    bf16_t* KT = (bf16_t*)(a.ws + WS_KT); bf16_t* AQK = (bf16_t*)(a.ws + WS_AQK); float* EGC = (float*)(a.ws + WS_EGC);
    const float* convw = a.in[8]; const float* a_log = a.in[9]; const float* dt_bias = a.in[10];
    const int hw = tid >> 8, t = tid & 255, wv = (tid >> 6) & 3, lane = tid & 63;
    LAS unsigned char* base = lds + hw * PREP_HALF;
    LAS bf16_t* Kb = (LAS bf16_t*)base; LAS bf16_t* Qb = (LAS bf16_t*)(base + 17408); LAS bf16_t* Vb = (LAS bf16_t*)(base + 2 * 17408);
    LAS float* Mf = (LAS float*)(base + 3 * 17408); LAS float* gcs = (LAS float*)(base + 4 * 17408); LAS float* betas = gcs + 64;
    for (int it = blockIdx.x; it < 1024; it += G) {
        const int ch = it * 2 + hw, b = ch >> 8, h = (ch >> 5) & 7, n = ch & 31;
        const int row0 = b * SEQ + n * 64;
        if (wv == 0) {
            const float av = AB[(size_t)(row0 + lane) * 16 + h], bv = AB[(size_t)(row0 + lane) * 16 + 8 + h];
            const float xx = av + dt_bias[h];
            const float sp = xx > 20.f ? xx : log1pf(expf(xx));
            float g = -expf(a_log[h]) * sp;
#pragma unroll
            for (int o = 1; o < 64; o <<= 1) { const float up = __shfl_up(g, o); if (lane >= o) g += up; }
            gcs[lane] = g; betas[lane] = pg8::sigm(bv);
        }
        {
            const int cgp = t & 15, rb = t >> 4;
#pragma unroll 1
            for (int ten = 0; ten < 3; ++ten) {
                const int colb = ten * 1024 + h * 128 + cgp * 8;
                f32x4 w[4][2];
#pragma unroll
                for (int j = 0; j < 4; ++j) { w[j][0] = *(const f32x4*)(convw + (size_t)j * 3072 + colb); w[j][1] = *(const f32x4*)(convw + (size_t)j * 3072 + colb + 4); }
#pragma unroll
                for (int i4 = 0; i4 < 4; ++i4) {
                    const int c = rb + 16 * i4;
                    float o[8] = {0.f, 0.f, 0.f, 0.f, 0.f, 0.f, 0.f, 0.f};
#pragma unroll
                    for (int j = 0; j < 4; ++j) {
                        const int rr = c - 3 + j; u32x4 x = (u32x4){0u, 0u, 0u, 0u};
                        if (rr >= 0) x = *(const u32x4*)(QKV + (size_t)(row0 + rr) * 3072 + colb);
                        else if (n > 0) x = *(const u32x4*)(HALO + (size_t)((b * 32 + n - 1) * 3 + 3 + rr) * 3072 + colb);
                        o[0] += bflo(x.x) * w[j][0][0]; o[1] += bfhi(x.x) * w[j][0][1]; o[2] += bflo(x.y) * w[j][0][2]; o[3] += bfhi(x.y) * w[j][0][3];
                        o[4] += bflo(x.z) * w[j][1][0]; o[5] += bfhi(x.z) * w[j][1][1]; o[6] += bflo(x.w) * w[j][1][2]; o[7] += bfhi(x.w) * w[j][1][3];
                    }
                    float ss = 0.f;
#pragma unroll
                    for (int i = 0; i < 8; ++i) { o[i] = pg8::silu(o[i]); ss += o[i] * o[i]; }
                    if (ten < 2) {
                        ss += __shfl_xor(ss, 1); ss += __shfl_xor(ss, 2); ss += __shfl_xor(ss, 4); ss += __shfl_xor(ss, 8);
                        const float sc = (1.f / sqrtf(ss + RMS_EPS)) * (ten == 0 ? 0.08838834764831845f : 1.f);
#pragma unroll
                        for (int i = 0; i < 8; ++i) o[i] *= sc;
                    }
                    u32x4 pk; pk.x = pk2(o[0], o[1]); pk.y = pk2(o[2], o[3]); pk.z = pk2(o[4], o[5]); pk.w = pk2(o[6], o[7]);
                    LAS bf16_t* dst = (ten == 0 ? Qb : (ten == 1 ? Kb : Vb)) + c * 136 + cgp * 8;
                    *(LAS u32x4*)dst = pk;
                }
            }
        }
        __syncthreads();
#pragma unroll
        for (int i4 = 0; i4 < 4; ++i4) { const int c = (t >> 4) + 16 * i4, cgp = t & 15;
            *(u32x4*)(QKV + (size_t)(row0 + c) * 3072 + h * 128 + cgp * 8) = *(const LAS u32x4*)(Qb + c * 136 + cgp * 8); }
        {
            const int ct = wv, l15 = lane & 15, q4 = lane >> 4;
            bf16x8 ak[4], aq[4];
#pragma unroll
            for (int ks = 0; ks < 4; ++ks) { ak[ks] = *(const LAS bf16x8*)(Kb + (ct * 16 + l15) * 136 + ks * 32 + q4 * 8); aq[ks] = *(const LAS bf16x8*)(Qb + (ct * 16 + l15) * 136 + ks * 32 + q4 * 8); }
            float gcr[4], btr[4];
#pragma unroll
            for (int r = 0; r < 4; ++r) { gcr[r] = gcs[ct * 16 + q4 * 4 + r]; btr[r] = betas[ct * 16 + q4 * 4 + r]; }
#pragma unroll
            for (int mt = 0; mt < 4; ++mt) {
                f32x4 kk = (f32x4){0.f, 0.f, 0.f, 0.f}, qk = (f32x4){0.f, 0.f, 0.f, 0.f};
                if (mt <= ct) {
#pragma unroll
                    for (int ks = 0; ks < 4; ++ks) { const bf16x8 bk = *(const LAS bf16x8*)(Kb + (mt * 16 + l15) * 136 + ks * 32 + q4 * 8);
                        kk = __builtin_amdgcn_mfma_f32_16x16x32_bf16(ak[ks], bk, kk, 0, 0, 0); qk = __builtin_amdgcn_mfma_f32_16x16x32_bf16(aq[ks], bk, qk, 0, 0, 0); }
                }
                const int mcol = mt * 16 + l15; const float gcm = gcs[mcol];
#pragma unroll
                for (int r = 0; r < 4; ++r) {
                    const int c = ct * 16 + q4 * 4 + r; const float dec = __expf(fminf(gcr[r] - gcm, 0.f));
                    Mf[c * 68 + mcol] = (mcol < c) ? btr[r] * kk[r] * dec : 0.f;
                    AQK[(size_t)ch * 4096 + c * 64 + mcol] = tobf((mcol <= c) ? qk[r] * dec : 0.f);
                }
            }
        }
        __syncthreads();
        {
            const int j = wv * 64 + lane;
            float x[64];
            if (j < 128) {
#pragma unroll
                for (int c = 0; c < 64; ++c) { x[c] = bf1(Vb[c * 136 + j]) * betas[c]; if ((c & 7) == 7) asm volatile("" ::: "memory"); }
            } else {
#pragma unroll
                for (int c = 0; c < 64; ++c) { x[c] = bf1(Kb[c * 136 + j - 128]) * betas[c] * __expf(gcs[c]); if ((c & 7) == 7) asm volatile("" ::: "memory"); }
            }
#pragma unroll
            for (int c = 1; c < 64; ++c) {
                float s = x[c];
#pragma unroll
                for (int m4 = 0; m4 < (c + 3) / 4; ++m4) {
                    const f32x4 mm = *(const LAS f32x4*)(Mf + c * 68 + 4 * m4);
#pragma unroll
                    for (int k = 0; k < 4; ++k) if (4 * m4 + k < c) s -= mm[k] * x[4 * m4 + k];
                }
                x[c] = s;
                asm volatile("" ::: "memory");
            }
            bf16_t* dst = QKV + (size_t)row0 * 3072 + (j < 128 ? 2048 + h * 128 + j : 1024 + h * 128 + (j - 128));
#pragma unroll
            for (int c = 0; c < 64; ++c) { *dst = tobf(x[c]); dst += 3072; asm volatile("" : "+v"(dst)); }
        }
        {
            const int d = t >> 1, c0 = (t & 1) * 32; const float gl = gcs[63];
#pragma unroll
            for (int c8 = 0; c8 < 4; ++c8) {
                float v[8];
#pragma unroll
                for (int i = 0; i < 8; ++i) { const int c = c0 + c8 * 8 + i; v[i] = bf1(Kb[c * 136 + d]) * __expf(gl - gcs[c]); }
                u32x4 pk; pk.x = pk2(v[0], v[1]); pk.y = pk2(v[2], v[3]); pk.z = pk2(v[4], v[5]); pk.w = pk2(v[6], v[7]);
                *(u32x4*)(KT + (size_t)ch * 8192 + d * 64 + c0 + c8 * 8) = pk;
            }
            if (t < 64) EGC[(size_t)ch * 64 + t] = __expf(gcs[t]);
        }
        __syncthreads();
    }
}

__device__ __forceinline__ void phase_gdn_scan(const Args& a, LAS unsigned char* lds, int G, int tid) {
    const bf16_t* QKV = (const bf16_t*)(a.ws + WS_QKV); const bf16_t* KT = (const bf16_t*)(a.ws + WS_KT); const bf16_t* AQK = (const bf16_t*)(a.ws + WS_AQK); const float* EGC = (const float*)(a.ws + WS_EGC);
    bf16_t* O = (bf16_t*)a.out;
    LAS bf16_t* ST = (LAS bf16_t*)lds;
    LAS bf16_t* VT = (LAS bf16_t*)(lds + 32 * 136 * 2);
    const int w = tid >> 6, lane = tid & 63, l15 = lane & 15, q4 = lane >> 4, ct = w >> 1, et = w & 1;
    for (int it = blockIdx.x; it < 256; it += G) {
        const int b = it >> 5, h = (it >> 2) & 7, e0 = (it & 3) * 32;
        f32x4 Sacc[2] = {(f32x4){0.f, 0.f, 0.f, 0.f}, (f32x4){0.f, 0.f, 0.f, 0.f}};
        for (int i = tid; i < 32 * 136 / 2; i += NTHR) ((LAS unsigned*)ST)[i] = 0u;
        __syncthreads();
        bf16x8 qA[4], wA[4], aA[2], kA[2]; float uu[4], eg[4], egl;
#define SCAN_LOAD(n_, Q, Wf, Af, Kf, U, E, EL) do { const int ch_ = (b * 8 + h) * 32 + (n_), row0_ = b * SEQ + (n_) * 64; \
            const bf16_t* rowp_ = QKV + (size_t)(row0_ + ct * 16 + l15) * 3072 + h * 128 + q4 * 8; \
            _Pragma("unroll") for (int ks = 0; ks < 4; ++ks) { Q[ks] = *(const bf16x8*)(rowp_ + ks * 32); Wf[ks] = *(const bf16x8*)(rowp_ + 1024 + ks * 32); } \
            _Pragma("unroll") for (int ks = 0; ks < 2; ++ks) { Af[ks] = *(const bf16x8*)(AQK + (size_t)ch_ * 4096 + (ct * 16 + l15) * 64 + ks * 32 + q4 * 8); Kf[ks] = *(const bf16x8*)(KT + (size_t)ch_ * 8192 + (w * 16 + l15) * 64 + ks * 32 + q4 * 8); } \
            _Pragma("unroll") for (int r = 0; r < 4; ++r) { const int c_ = ct * 16 + q4 * 4 + r; U[r] = bf1(QKV[(size_t)(row0_ + c_) * 3072 + 2048 + h * 128 + e0 + et * 16 + l15]); E[r] = EGC[(size_t)ch_ * 64 + c_]; } \
            EL = EGC[(size_t)ch_ * 64 + 63]; } while (0)
        SCAN_LOAD(0, qA, wA, aA, kA, uu, eg, egl);
        for (int n = 0; n < 32; ++n) {
            const int row0 = b * SEQ + n * 64;
            bf16x8 qN[4], wN[4], aN[2], kN[2]; float uN[4], eN[4], elN;
            { const int nn = n < 31 ? n + 1 : n; SCAN_LOAD(nn, qN, wN, aN, kN, uN, eN, elN); }
            f32x4 wsv = (f32x4){0.f, 0.f, 0.f, 0.f}, qsv = (f32x4){0.f, 0.f, 0.f, 0.f};
#pragma unroll
            for (int ks = 0; ks < 4; ++ks) { const bf16x8 sB = *(const LAS bf16x8*)(ST + (et * 16 + l15) * 136 + ks * 32 + q4 * 8);
                wsv = __builtin_amdgcn_mfma_f32_16x16x32_bf16(wA[ks], sB, wsv, 0, 0, 0); qsv = __builtin_amdgcn_mfma_f32_16x16x32_bf16(qA[ks], sB, qsv, 0, 0, 0); }
            { u32x2 pk; pk.x = pk2(uu[0] - wsv[0], uu[1] - wsv[1]); pk.y = pk2(uu[2] - wsv[2], uu[3] - wsv[3]);
              *(LAS u32x2*)(VT + (et * 16 + l15) * 72 + ct * 16 + q4 * 4) = pk; }
            asm volatile("s_waitcnt lgkmcnt(0)" ::: "memory"); __builtin_amdgcn_s_barrier(); asm volatile("" ::: "memory");
            f32x4 av = (f32x4){0.f, 0.f, 0.f, 0.f};
#pragma unroll
            for (int ks = 0; ks < 2; ++ks) { const bf16x8 vB = *(const LAS bf16x8*)(VT + (et * 16 + l15) * 72 + ks * 32 + q4 * 8); av = __builtin_amdgcn_mfma_f32_16x16x32_bf16(aA[ks], vB, av, 0, 0, 0); }
#pragma unroll
            for (int r = 0; r < 4; ++r) { const int c = ct * 16 + q4 * 4 + r; O[(size_t)(row0 + c) * DM + h * 128 + e0 + et * 16 + l15] = tobf(qsv[r] * eg[r] + av[r]); }
#pragma unroll
            for (int e2 = 0; e2 < 2; ++e2) {
                f32x4 up = (f32x4){0.f, 0.f, 0.f, 0.f};
#pragma unroll
                for (int ks = 0; ks < 2; ++ks) { const bf16x8 vB = *(const LAS bf16x8*)(VT + (e2 * 16 + l15) * 72 + ks * 32 + q4 * 8); up = __builtin_amdgcn_mfma_f32_16x16x32_bf16(kA[ks], vB, up, 0, 0, 0); }
                Sacc[e2] = Sacc[e2] * egl + up;
                u32x2 pk; pk.x = pk2(Sacc[e2][0], Sacc[e2][1]); pk.y = pk2(Sacc[e2][2], Sacc[e2][3]);
                *(LAS u32x2*)(ST + (e2 * 16 + l15) * 136 + w * 16 + q4 * 4) = pk;
            }
            asm volatile("s_waitcnt lgkmcnt(0)" ::: "memory"); __builtin_amdgcn_s_barrier(); asm volatile("" ::: "memory");
#pragma unroll
            for (int ks = 0; ks < 4; ++ks) { qA[ks] = qN[ks]; wA[ks] = wN[ks]; }
#pragma unroll
            for (int ks = 0; ks < 2; ++ks) { aA[ks] = aN[ks]; kA[ks] = kN[ks]; }
#pragma unroll
            for (int r = 0; r < 4; ++r) { uu[r] = uN[r]; eg[r] = eN[r]; }
            egl = elN;
        }
#undef SCAN_LOAD
    }
}

#define XB_TMO      128
#define XB_XCNT(j)  (256  + 64 * (j))
#define XB_XSUB(j)  (1280 + 64 * (j))
#define XB_XGEN(j)  (2304 + 64 * (j))
#define XB_TOP      3328
#define XB_TOPGEN   3392
#define XCD_BAR_WORDS 3456
#define XB_SPIN_CAP (1u << 18)

__device__ __forceinline__ unsigned xb_ld(unsigned* p)              { return __hip_atomic_load(p, __ATOMIC_RELAXED, __HIP_MEMORY_SCOPE_AGENT); }
__device__ __forceinline__ unsigned xb_add(unsigned* p, unsigned v) { return __hip_atomic_fetch_add(p, v, __ATOMIC_RELAXED, __HIP_MEMORY_SCOPE_AGENT); }
__device__ __forceinline__ unsigned xb_xcc_id() { return (unsigned)__builtin_amdgcn_s_getreg((3 << 11) | 20) & 0xFu; }
#define XB_SPIN(cond, bar) do { unsigned _sp = 0; while (cond) { __builtin_amdgcn_s_sleep(1); \
    if ((++_sp & 255u) == 0u) { if (xb_ld(&(bar)[XB_TMO])) break; if (_sp > XB_SPIN_CAP) { atomicAdd(&(bar)[XB_TMO], 1u); break; } } } } while (0)

struct XcdBarrier {
    unsigned* bar; unsigned x;
    volatile __attribute__((address_space(3))) unsigned* st;
};

__device__ __forceinline__ XcdBarrier xcd_barrier_post(unsigned* bar, volatile __attribute__((address_space(3))) unsigned* st) {
    XcdBarrier b; b.bar = bar; b.x = xb_xcc_id(); b.st = st;
    if (threadIdx.x == 0) (void)xb_add(&bar[XB_XCNT(b.x)], 1u);
    return b;
}
__device__ __forceinline__ void xcd_barrier_complete(unsigned* bar, unsigned x, unsigned& nloc, unsigned& nx) {
    const unsigned G = gridDim.x * gridDim.y * gridDim.z;
    unsigned sum, cnt, mine, sp = 0u;
    for (;;) {
        sum = 0u; cnt = 0u; mine = 0u;
#pragma unroll
        for (unsigned j = 0; j < 16; ++j) { const unsigned c = xb_ld(&bar[XB_XCNT(j)]); sum += c; cnt += (c > 0u) ? 1u : 0u; mine = (j == x) ? c : mine; }
        if (sum == G) break;
        __builtin_amdgcn_s_sleep(1);
        if ((++sp & 255u) == 0u) { if (xb_ld(&bar[XB_TMO])) break; if (sp > XB_SPIN_CAP) { atomicAdd(&bar[XB_TMO], 1u); break; } }
    }
    nloc = mine > 0u ? mine : 1u; nx = cnt > 0u ? cnt : 1u;
}

__device__ __forceinline__ void xcd_barrier(const XcdBarrier& b) {
    asm volatile("s_waitcnt vmcnt(0)" ::: "memory");
    __syncthreads();
    if (threadIdx.x == 0) {
        unsigned* bar = b.bar;
        __builtin_amdgcn_s_waitcnt(0);
        unsigned nloc = b.st[0], nx = b.st[1];
        if (nloc == 0u) { xcd_barrier_complete(bar, b.x, nloc, nx); b.st[0] = nloc; b.st[1] = nx; }
        const unsigned old = xb_add(&bar[XB_XSUB(b.x)], 1u);
        const unsigned gen = old / nloc;
        if (old + 1u == (gen + 1u) * nloc) {
            __builtin_amdgcn_fence(__ATOMIC_RELEASE, "agent");
            asm volatile("s_waitcnt vmcnt(0)" ::: "memory");
            const unsigned og = xb_add(&bar[XB_TOP], 1u);
            const unsigned tg = og / nx;
            if (og + 1u == (tg + 1u) * nx) xb_add(&bar[XB_TOPGEN], 1u);
            else XB_SPIN(xb_ld(&bar[XB_TOPGEN]) == tg, bar);
            __builtin_amdgcn_fence(__ATOMIC_ACQUIRE, "agent");
            xb_add(&bar[XB_XGEN(b.x)], 1u);
            asm volatile("s_waitcnt vmcnt(0)" ::: "memory");
        } else {
            XB_SPIN(xb_ld(&bar[XB_XGEN(b.x)]) == gen, bar);
            __builtin_amdgcn_fence(__ATOMIC_ACQUIRE, "agent");
            asm volatile("s_waitcnt vmcnt(0)" ::: "memory");
        }
    }
    __syncthreads();
}

__device__ __forceinline__ void grid_bar(unsigned* cnt, unsigned target) {
    asm volatile("s_waitcnt vmcnt(0) lgkmcnt(0)" ::: "memory");
    __syncthreads();
    if (threadIdx.x == 0) {
        __builtin_amdgcn_fence(__ATOMIC_RELEASE, "agent");
        asm volatile("s_waitcnt vmcnt(0)" ::: "memory");
        __hip_atomic_fetch_add(cnt, 1u, __ATOMIC_RELAXED, __HIP_MEMORY_SCOPE_AGENT);
        unsigned spins = 0;
        while (__hip_atomic_load(cnt, __ATOMIC_RELAXED, __HIP_MEMORY_SCOPE_AGENT) < target) { __builtin_amdgcn_s_sleep(1); if (++spins > (1u << 24)) break; }
    }
    __syncthreads();
    asm volatile("buffer_inv sc1\n\ts_waitcnt vmcnt(0)" ::: "memory");
    __syncthreads();
}
struct AttnQKOrder {
    int G, c;
    __device__ __forceinline__ bool next(int i, pg8::Unit& u) const { const int L = i * G + c; if (L >= 256) return false; const int b = L >> 5, h = (L >> 3) & 3, qt = L & 7;
        u.pm = b * 8 + qt; u.pn = b; u.aoff = (unsigned)h * 512u; u.boff = (unsigned)h * 512u; u.tag = L; return true; }
};
struct AttnPVOrder {
    int G, c;
    __device__ __forceinline__ bool next(int i, pg8::Unit& u) const { const int L = i * G + c; if (L >= 256) return false; u.pm = L; u.pn = L >> 3; u.aoff = 0; u.boff = 0; u.tag = L; return true; }
    __device__ __forceinline__ void a_ready(const pg8::Unit&) const {}
    __device__ __forceinline__ void done(const pg8::Unit&) const {}
};

#ifndef PH_LAST
#define PH_LAST 19
#endif
#ifndef PH_MASK
#define PH_MASK 0xFFFFFu
#endif

__global__ void __launch_bounds__(NTHR, 2) fwd_kernel(Args a) {
    extern __shared__ __attribute__((aligned(16))) unsigned char lds_raw[];
    cg::grid_group grid = cg::this_grid();
    LAS unsigned char* lds = (LAS unsigned char*)lds_raw;
    const int G = gridDim.x, bx = blockIdx.x, NGW = G * NWAVES;
#define IDS int tid = threadIdx.x; asm volatile("" : "+v"(tid)); const int lane = tid & 63, wave = __builtin_amdgcn_readfirstlane(tid >> 6), gw = bx * NWAVES + wave; (void)lane; (void)gw;
    unsigned char* ws = a.ws;
    bf16_t* XB = (bf16_t*)(ws + WS_XB);
    float* XF = a.out;
    const int lo = a.ph_lo, hi = a.ph_hi;
    { volatile LAS unsigned* stw = (volatile LAS unsigned*)(lds + LDS_BYTES - 64); if (threadIdx.x < 4) stw[threadIdx.x] = 0u; }
    __syncthreads();
    XcdBarrier xbar = xcd_barrier_post((unsigned*)(ws + WS_CTL), (volatile LAS unsigned*)(lds + LDS_BYTES - 64));
    if (lo > 1000) grid.sync();
#define IN(k) (lo <= (k) && (k) <= hi && (k) <= PH_LAST && ((PH_MASK >> (k)) & 1u))
#define SEAM(k) do { if (IN(k) && IN((k) + 1)) { xcd_barrier(xbar); } } while (0)
    using namespace pg8;

    if (IN(0)) { IDS phase_prologue(a, lds, gw, NGW, wave, lane); }
    SEAM(0);
    if (IN(1)) {
        { Gemm g{XB, (const bf16_t*)(ws + W_GU1), DM, DM, DM}; StaticOrder S; S.init(M, 2 * DFF, G, bx); EpiPair<0> E{(bf16_t*)(ws + WS_H), DFF, 0};
          gemm_phase<EpiPair<0>, StaticOrder, true, true>(lds, g, S, E); }
        __syncthreads();
        { Gemm g{(const bf16_t*)(ws + WS_MEMB), (const bf16_t*)(ws + W_XKV), DM, DM, DM}; KVOrder S{G, bx}; EpiKV E{(bf16_t*)(ws + WS_K), (bf16_t*)(ws + WS_VT)};
          gemm_phase<EpiKV, KVOrder, true, true>(lds, g, S, E); }
    }
    SEAM(1);
    if (IN(2)) {
        Gemm g{(const bf16_t*)(ws + WS_H), (const bf16_t*)(ws + W_D1), DFF, DFF, DFF}; StaticOrder S; S.init(M, DM, G, bx); EpiResid<false> E{a.in[0], XF, ALPHA, 0.5f};
        gemm_phase<EpiResid<false>, StaticOrder, true, true>(lds, g, S, E);
    }
    SEAM(2);
    if (IN(3)) { IDS phase_ln(XF, nullptr, XB, a.in[5], a.in[6], gw, NGW, lane); }
    SEAM(3);
    if (IN(4)) {
        Gemm g{XB, (const bf16_t*)(ws + W_INA), DM, DM, DM}; StaticOrder S; S.init(M, 3328, G, bx); EpiQKV E{(bf16_t*)(ws + WS_QKV), (bf16_t*)(ws + WS_HALO), (float*)(ws + WS_AB)};
        gemm_phase<EpiQKV, StaticOrder, true, true>(lds, g, S, E);
    }
    SEAM(4);
    if (IN(5)) { IDS phase_gdn_prep(a, lds, G, tid); }
    SEAM(5);
    if (IN(6)) { IDS phase_gdn_scan(a, lds, G, tid); }
    SEAM(6);
    if (IN(7)) {
        { Gemm g{XB, (const bf16_t*)(ws + W_INB), DM, DM, DM}; StaticOrder S; S.init(M, 3072, G, bx); EpiZGG E{(bf16_t*)((unsigned char*)a.out + 32 * MiB), (bf16_t*)(ws + WS_C), (bf16_t*)(ws + WS_G)};
          gemm_phase<EpiZGG, StaticOrder, true, true>(lds, g, S, E); }
        __syncthreads();
        { Gemm g{XB, (const bf16_t*)(ws + W_INB) + (size_t)3072 * DM, DM, DM, DM}; StaticOrder S; S.init(M, 2048, G, bx); EpiAct<2> E{(bf16_t*)(ws + WS_G), 2048, 0};
          gemm_phase<EpiAct<2>, StaticOrder, true, true>(lds, g, S, E); }
    }
    SEAM(7);
    if (IN(8)) { IDS
        phase_conv31((const bf16_t*)(ws + WS_C), (bf16_t*)(ws + WS_CC), a.in[13], a.in[14], a.in[15], a.in[16], lds, G, tid);
        phase_gate_rms((bf16_t*)a.out, (const bf16_t*)((unsigned char*)a.out + 32 * MiB), a.in[11], gw, NGW, lane);
    }
    SEAM(8);
    if (IN(9)) {
        bf16_t* T = (bf16_t*)((unsigned char*)a.out + 32 * MiB);
        { Gemm g{(const bf16_t*)a.out, (const bf16_t*)(ws + W_GDN), DM, DM, DM}; StaticOrder S; S.init(M, DM, G, bx); EpiGate1 E{(const bf16_t*)(ws + WS_G), T};
          gemm_phase<EpiGate1, StaticOrder, true, true>(lds, g, S, E); }
        __syncthreads();
        { Gemm g{(const bf16_t*)(ws + WS_CC), (const bf16_t*)(ws + W_CONV), DM, DM, DM}; StaticOrder S; S.init(M, DM, G, bx); EpiGate2 E{(const bf16_t*)(ws + WS_G), T, a.in[18], (bf16_t*)(ws + WS_YMIX)};
          gemm_phase<EpiGate2, StaticOrder, true, true>(lds, g, S, E); }
    }
    SEAM(9);
    if (IN(10)) {
        Gemm g{(const bf16_t*)(ws + WS_YMIX), (const bf16_t*)(ws + W_MIX), DM, DM, DM}; StaticOrder S; S.init(M, DM, G, bx); EpiResid<true> E{XB, XF, ALPHA, 1.0f};
        gemm_phase<EpiResid<true>, StaticOrder, true, true>(lds, g, S, E);
    }
    SEAM(10);
    if (IN(11)) { IDS phase_ln(XF, nullptr, XB, a.in[20], a.in[21], gw, NGW, lane); }
    SEAM(11);
    if (IN(12)) {
        Gemm g{XB, (const bf16_t*)(ws + W_XQ), DM, DM, DM}; StaticOrder S; S.init(M, DM, G, bx); EpiAct<0> E{(bf16_t*)(ws + WS_Q), DM, 0};
        gemm_phase<EpiAct<0>, StaticOrder, true, true>(lds, g, S, E);
    }
    SEAM(12);
    if (IN(13)) {
        int k256 = 256; asm volatile("" : "+s"(k256));
        Gemm g{(const bf16_t*)(ws + WS_Q), (const bf16_t*)(ws + WS_K), k256, DM, DM}; AttnQKOrder S{G, bx}; EpiSoftmax E{(bf16_t*)(ws + WS_P), 0.0625f};
        Unit u;
        for (int i = 0; S.next(i, u); ++i) { SingleUnit s1{u}; gemm_phase<EpiSoftmax, SingleUnit, false, true>(lds, g, s1, E); __syncthreads(); }
    }
    SEAM(13);
    if (IN(14)) {
        int k256 = 256; asm volatile("" : "+s"(k256));
        Gemm g{(const bf16_t*)(ws + WS_P), (const bf16_t*)(ws + WS_VT), k256, 256, 256}; AttnPVOrder S{G, bx}; EpiPlainNP E{(bf16_t*)(ws + WS_O), DM, 1};
        gemm_phase<EpiPlainNP, AttnPVOrder, true, true>(lds, g, S, E);
    }
    SEAM(14);
    if (IN(15)) {
        Gemm g{(const bf16_t*)(ws + WS_O), (const bf16_t*)(ws + W_XO), DM, DM, DM}; StaticOrder S; S.init(M, DM, G, bx); EpiResid<true> E{XB, XF, ALPHA, 1.0f};
        gemm_phase<EpiResid<true>, StaticOrder, true, true>(lds, g, S, E);
    }
    SEAM(15);
    if (IN(16)) { IDS phase_ln(XF, nullptr, XB, a.in[25], a.in[26], gw, NGW, lane); }
    SEAM(16);
    if (IN(17)) {
        Gemm g{XB, (const bf16_t*)(ws + W_GU2), DM, DM, DM}; StaticOrder S; S.init(M, 2 * DFF, G, bx); EpiPair<0> E{(bf16_t*)(ws + WS_H), DFF, 0};
        gemm_phase<EpiPair<0>, StaticOrder, true, true>(lds, g, S, E);
    }
    SEAM(17);
    if (IN(18)) {
        Gemm g{(const bf16_t*)(ws + WS_H), (const bf16_t*)(ws + W_D2), DFF, DFF, DFF}; StaticOrder S; S.init(M, DM, G, bx); EpiResid<true> E{XB, XF, ALPHA, 0.5f};
        gemm_phase<EpiResid<true>, StaticOrder, true, true>(lds, g, S, E);
    }
    SEAM(18);
    if (IN(19)) { IDS phase_ln(XF, XF, nullptr, a.in[30], a.in[31], gw, NGW, lane); }
#undef IN
#undef SEAM
}

extern "C" void kernel_launch(void* const* d_in, const int* in_sizes, int n_in, void* d_out, int out_size, void* d_ws, size_t ws_size, hipStream_t stream) {
    static int grid_blocks = 0;
    if (!grid_blocks) {
        int dev = 0, cus = 0, per_cu = 0;
        hipGetDevice(&dev);
        hipDeviceGetAttribute(&cus, hipDeviceAttributeMultiprocessorCount, dev);
        hipFuncSetAttribute((const void*)fwd_kernel, hipFuncAttributeMaxDynamicSharedMemorySize, LDS_BYTES);
        hipOccupancyMaxActiveBlocksPerMultiprocessor(&per_cu, (const void*)fwd_kernel, NTHR, LDS_BYTES);
        if (per_cu < 1) { fprintf(stderr, "occupancy query says %d blocks/CU\n", per_cu); per_cu = 1; }
        grid_blocks = cus * per_cu;
        if (grid_blocks > 256) grid_blocks = 256;
    }
    (void)hipMemsetAsync((char*)d_ws + WS_CTL, 0, 16384, stream);
    Args a{};
    for (int i = 0; i < 32; ++i) a.in[i] = (const float*)d_in[i];
    a.out = (float*)d_out; a.ws = (unsigned char*)d_ws; a.ph_lo = 0; a.ph_hi = 99;
    void* args[] = {&a};
    hipError_t e = hipLaunchCooperativeKernel((const void*)fwd_kernel, dim3(grid_blocks), dim3(NTHR), args, LDS_BYTES, stream);
    if (e != hipSuccess) fprintf(stderr, "cooperative launch failed: %s (grid %d)\n", hipGetErrorString(e), grid_blocks);
}
```
